# Optimizing an MI355X kernel written in HIP

```python
import math
import jax, jax.numpy as jnp
from jax import lax
import numpy as np

D_MODEL = 2048
BATCH = 4
SEQ = 4096
DEPTH = 2

QBLOCK = 128
RMS_EPS = 1e-6
NEG_INF = -1e30
D_FF = 5632

MLA_HEADS = 4
MLA_Q_RANK = 512
MLA_KV_RANK = 256
MLA_NOPE = 128
MLA_ROPE = 64
MLA_V = 128
ROPE_THETA = 10000.0

DIFF_HEADS = 4
DIFF_QK = 64
DIFF_V = 128

NSA_HEADS = 4
NSA_D = 128
NSA_CMP_LEN = 32
NSA_CMP_STRIDE = 16
NSA_SEL_BLOCK = 64
NSA_N_SELECT = 16
NSA_WINDOW = 512
NSA_FORCE_BONUS = 1e4

SB_HEADS = 4
SB_D = 128

N_ALIBI_HEADS = DIFF_HEADS + NSA_HEADS
MIX_WIDTH = MLA_HEADS * MLA_V + DIFF_HEADS * DIFF_V + NSA_HEADS * NSA_D + SB_HEADS * SB_D

IN_SIZES = (
    MLA_Q_RANK, MLA_KV_RANK, MLA_ROPE,
    DIFF_HEADS * 2 * DIFF_QK, DIFF_HEADS * 2 * DIFF_QK, DIFF_HEADS * DIFF_V,
    NSA_HEADS * NSA_D, NSA_D, NSA_D, NSA_D, NSA_D, NSA_D, NSA_D, NSA_HEADS * 3,
    SB_HEADS * SB_D, SB_HEADS * SB_D, SB_HEADS * SB_D,
)
D_IN = sum(IN_SIZES)

kernel_name = 'hybrid_mla_diff_nsa_stickbreak_macaron'


def _in_offsets():
    offs, acc = [], 0
    for w in IN_SIZES[:-1]:
        acc += w
        offs.append(acc)
    return offs


def _rms(x, g):
    xf = x.astype(jnp.float32)
    y = xf * lax.rsqrt(jnp.mean(xf * xf, axis=-1, keepdims=True) + RMS_EPS)
    return (y * g.astype(jnp.float32)).astype(x.dtype)


def _swiglu(x, w_gate, w_up, w_down):
    return (jax.nn.silu(x @ w_gate) * (x @ w_up)) @ w_down


def _heads(x, h):
    b, s, c = x.shape
    return x.reshape(b, s, h, c // h).transpose(0, 2, 1, 3)


def _merge(x):
    b, h, s, d = x.shape
    return x.transpose(0, 2, 1, 3).reshape(b, s, h * d)


def _to_qblocks(x):
    b, h, s, d = x.shape
    return x.reshape(b, h, s // QBLOCK, QBLOCK, d).transpose(2, 0, 1, 3, 4)


def _from_qblocks(y):
    nb, b, h, qb, d = y.shape
    return y.transpose(1, 2, 0, 3, 4).reshape(b, h, nb * qb, d)


def _sweep(fn, *qs):
    nb = qs[0].shape[2] // QBLOCK
    out = lax.map(lambda a: fn(*a), (jnp.arange(nb), *[_to_qblocks(z) for z in qs]))
    return _from_qblocks(out)


def _masked_softmax(s, mask):
    s = jnp.where(mask, s.astype(jnp.float32), NEG_INF)
    m = jnp.max(s, axis=-1, keepdims=True)
    e = jnp.where(mask, jnp.exp(s - m), 0.0)
    return e / jnp.maximum(jnp.sum(e, axis=-1, keepdims=True), 1e-30)


def _rope(x, cos, sin):
    xf = x.astype(jnp.float32)
    x1, x2 = jnp.split(xf, 2, axis=-1)
    return jnp.concatenate([x1 * cos - x2 * sin, x2 * cos + x1 * sin], axis=-1).astype(x.dtype)


def _alibi_slopes(n):
    return 2.0 ** (-8.0 * jnp.arange(1, n + 1, dtype=jnp.float32) / n)


def _mla(c_q, c_kv, k_rope, cq_norm, ckv_norm, w_uq, w_ukv, qn_norm, qr_norm, kn_norm, kr_norm, o_norm, cos, sin):
    q = _heads(_rms(c_q, cq_norm) @ w_uq, MLA_HEADS)
    kv = _heads(_rms(c_kv, ckv_norm) @ w_ukv, MLA_HEADS)
    q_nope = _rms(q[..., :MLA_NOPE], qn_norm)
    q_rope = _rope(_rms(q[..., MLA_NOPE:], qr_norm), cos, sin)
    k_nope = _rms(kv[..., :MLA_NOPE], kn_norm)
    v = kv[..., MLA_NOPE:]
    k_r = _rope(_rms(k_rope, kr_norm), cos, sin)
    s = q.shape[2]
    kpos = jnp.arange(s)
    scale = (MLA_NOPE + MLA_ROPE) ** -0.5

    def block(i, qn, qr):
        t = i * QBLOCK + jnp.arange(QBLOCK)
        sc = (jnp.einsum('bhqd,bhkd->bhqk', qn, k_nope).astype(jnp.float32)
              + jnp.einsum('bhqr,bkr->bhqk', qr, k_r).astype(jnp.float32)) * scale
        p = _masked_softmax(sc, kpos[None, :] <= t[:, None])
        return jnp.einsum('bhqk,bhkd->bhqd', p.astype(v.dtype), v)

    o = _sweep(block, q_nope, q_rope)
    return _merge(_rms(o, o_norm))


def _diff(q, k, v, q_norm, k_norm, lq1, lk1, lq2, lk2, subln, slopes, lambda_init):
    b, s, _ = q.shape
    f32 = jnp.float32

    def split2(z):
        z = z.reshape(b, s, DIFF_HEADS, 2, DIFF_QK).transpose(3, 0, 2, 1, 4)
        return z[0], z[1]

    q1, q2 = split2(q)
    k1, k2 = split2(k)
    q1, q2 = _rms(q1, q_norm), _rms(q2, q_norm)
    k1, k2 = _rms(k1, k_norm), _rms(k2, k_norm)
    vh = _heads(v, DIFF_HEADS)
    lam = (jnp.exp(jnp.sum(lq1.astype(f32) * lk1.astype(f32)))
           - jnp.exp(jnp.sum(lq2.astype(f32) * lk2.astype(f32))) + lambda_init)
    kpos = jnp.arange(s)
    scale = DIFF_QK ** -0.5

    def block(i, q1b, q2b):
        t = i * QBLOCK + jnp.arange(QBLOCK)
        mask = kpos[None, :] <= t[:, None]
        bias = -slopes[:, None, None] * (t[:, None] - kpos[None, :]).astype(f32)
        s1 = jnp.einsum('bhqd,bhkd->bhqk', q1b, k1).astype(f32) * scale + bias
        s2 = jnp.einsum('bhqd,bhkd->bhqk', q2b, k2).astype(f32) * scale + bias
        p = _masked_softmax(s1, mask) - lam * _masked_softmax(s2, mask)
        return jnp.einsum('bhqk,bhkd->bhqd', p.astype(vh.dtype), vh)

    o = _sweep(block, q1, q2)
    return _merge(_rms(o, subln) * (1.0 - lambda_init))


def _nsa(q, kc_raw, vc_raw, ks, vs, kw, vw, gate_logits, q_norm, pe_k, w_ck, pe_v, w_cv,
         kc_norm, ks_norm, kw_norm, o_norm, slopes):
    b, s, _ = q.shape
    f32 = jnp.float32
    qh = _rms(_heads(q, NSA_HEADS), q_norm)
    gates = jax.nn.sigmoid(gate_logits.astype(f32)).reshape(b, s, NSA_HEADS, 3).transpose(0, 2, 1, 3)

    n_cmp = (s - NSA_CMP_LEN) // NSA_CMP_STRIDE + 1
    c_start = NSA_CMP_STRIDE * jnp.arange(n_cmp)
    tok = c_start[:, None] + jnp.arange(NSA_CMP_LEN)[None, :]
    c_end = c_start + NSA_CMP_LEN - 1

    def compress(z, pe, w):
        blocks = z[:, tok] + pe
        return blocks.reshape(b, n_cmp, NSA_CMP_LEN * NSA_D) @ w

    kc = _rms(compress(kc_raw, pe_k, w_ck), kc_norm)
    vc = compress(vc_raw, pe_v, w_cv)

    n_sb = s // NSA_SEL_BLOCK
    n_sel = min(NSA_N_SELECT, n_sb)
    ks_b = _rms(ks, ks_norm).reshape(b, n_sb, NSA_SEL_BLOCK, NSA_D)
    vs_b = vs.reshape(b, n_sb, NSA_SEL_BLOCK, NSA_D)
    sel_start = NSA_SEL_BLOCK * jnp.arange(n_sb)
    overlap = ((c_start[:, None] < sel_start[None, :] + NSA_SEL_BLOCK)
               & (c_start[:, None] + NSA_CMP_LEN > sel_start[None, :])).astype(f32)

    kw_p = jnp.pad(_rms(kw, kw_norm), ((0, 0), (NSA_WINDOW, 0), (0, 0)))
    vw_p = jnp.pad(vw, ((0, 0), (NSA_WINDOW, 0), (0, 0)))

    scale = NSA_D ** -0.5
    slope4 = slopes[None, :, None, None]
    jb = jnp.arange(n_sb)

    def block(i, qb, gb):
        t = i * QBLOCK + jnp.arange(QBLOCK)
        tf = t.astype(f32)
        sc = (jnp.einsum('bhqd,bnd->bhqn', qb, kc).astype(f32) * scale
              - slope4 * (tf[:, None] - c_end[None, :].astype(f32)))
        pc = _masked_softmax(sc, c_end[None, :] <= t[:, None])
        oc = jnp.einsum('bhqn,bnd->bhqd', pc.astype(vc.dtype), vc).astype(f32)
        imp = jnp.einsum('bhqn,nj->bqj', pc, overlap)
        cur = t // NSA_SEL_BLOCK
        valid = sel_start[None, :] <= t[:, None]
        forced = (jb[None, :] == 0) | (jb[None, :] == cur[:, None]) | (jb[None, :] == cur[:, None] - 1)
        score = jnp.where(valid, imp + jnp.where(forced, NSA_FORCE_BONUS, 0.0), NEG_INF)
        top_val, top_idx = lax.top_k(score, n_sel)
        picked = top_val > 0.5 * NEG_INF
        kg = jax.vmap(lambda kb_, ib_: kb_[ib_])(ks_b, top_idx)
        vg = jax.vmap(lambda vb_, ib_: vb_[ib_])(vs_b, top_idx)
        pos = top_idx[..., None] * NSA_SEL_BLOCK + jnp.arange(NSA_SEL_BLOCK)
        ms = picked[..., None] & (pos <= t[None, :, None, None])
        ss = (jnp.einsum('bhqd,bqnkd->bhqnk', qb, kg).astype(f32) * scale
              - slope4[..., None] * (tf[None, :, None, None] - pos.astype(f32))[:, None])
        m_tok = n_sel * NSA_SEL_BLOCK
        ps = _masked_softmax(ss.reshape(b, NSA_HEADS, QBLOCK, m_tok), ms.reshape(b, 1, QBLOCK, m_tok))
        osel = jnp.einsum('bhqm,bqmd->bhqd', ps.astype(vg.dtype), vg.reshape(b, QBLOCK, m_tok, NSA_D)).astype(f32)
        kwin = lax.dynamic_slice_in_dim(kw_p, i * QBLOCK, QBLOCK + NSA_WINDOW, axis=1)
        vwin = lax.dynamic_slice_in_dim(vw_p, i * QBLOCK, QBLOCK + NSA_WINDOW, axis=1)
        kp = i * QBLOCK - NSA_WINDOW + jnp.arange(QBLOCK + NSA_WINDOW)
        mw = (kp[None, :] <= t[:, None]) & (t[:, None] - kp[None, :] < NSA_WINDOW) & (kp[None, :] >= 0)
        sw = (jnp.einsum('bhqd,bkd->bhqk', qb, kwin).astype(f32) * scale
              - slope4 * (tf[:, None] - kp[None, :].astype(f32)))
        pw = _masked_softmax(sw, mw)
        ow = jnp.einsum('bhqk,bkd->bhqd', pw.astype(vwin.dtype), vwin).astype(f32)
        g = gb.astype(f32)
        o = g[..., 0:1] * oc + g[..., 1:2] * osel + g[..., 2:3] * ow
        return o.astype(qb.dtype)

    o = _sweep(block, qh, gates)
    return _merge(_rms(o, o_norm))


def _stick_breaking(q, k, v, o_norm):
    qh, kh, vh = _heads(q, SB_HEADS), _heads(k, SB_HEADS), _heads(v, SB_HEADS)
    s = qh.shape[2]
    kpos = jnp.arange(s)
    scale = SB_D ** -0.5

    def block(i, qb):
        t = i * QBLOCK + jnp.arange(QBLOCK)
        z = jnp.einsum('bhqd,bhkd->bhqk', qb, kh).astype(jnp.float32) * scale
        mask = kpos[None, :] < t[:, None]
        log_not = jnp.where(mask, jax.nn.log_sigmoid(-z), 0.0)
        after = lax.cumsum(log_not, axis=3, reverse=True) - log_not
        a = jnp.where(mask, jnp.exp(jax.nn.log_sigmoid(z) + after), 0.0)
        return jnp.einsum('bhqk,bhkd->bhqd', a.astype(vh.dtype), vh)

    o = _sweep(block, qh)
    return _merge(_rms(o, o_norm))


def setup_inputs(seed: int = 0) -> dict:
    key = jax.random.key(seed)
    keys = iter(jax.random.split(key, 64))
    L, D, F = DEPTH, D_MODEL, D_FF
    f32 = jnp.float32

    def dense(shape, fan_in):
        return jax.random.normal(next(keys), shape, f32) * fan_in ** -0.5

    def gain(shape):
        return 1.0 + 0.05 * jax.random.normal(next(keys), shape, f32)

    def small(shape, sc):
        return sc * jax.random.normal(next(keys), shape, f32)

    return {
        'x': jax.random.normal(next(keys), (BATCH, SEQ, D), f32),
        'ffn1_norm': gain((L, D)),
        'ffn1_w_gate': dense((L, D, F), D),
        'ffn1_w_up': dense((L, D, F), D),
        'ffn1_w_down': dense((L, F, D), F),
        'mix_norm': gain((L, D)),
        'w_in': dense((L, D, D_IN), D),
        'mla_cq_norm': gain((L, MLA_Q_RANK)),
        'mla_ckv_norm': gain((L, MLA_KV_RANK)),
        'mla_w_uq': dense((L, MLA_Q_RANK, MLA_HEADS * (MLA_NOPE + MLA_ROPE)), MLA_Q_RANK),
        'mla_w_ukv': dense((L, MLA_KV_RANK, MLA_HEADS * (MLA_NOPE + MLA_V)), MLA_KV_RANK),
        'mla_qn_norm': gain((L, MLA_NOPE)),
        'mla_qr_norm': gain((L, MLA_ROPE)),
        'mla_kn_norm': gain((L, MLA_NOPE)),
        'mla_kr_norm': gain((L, MLA_ROPE)),
        'mla_o_norm': gain((L, MLA_V)),
        'diff_q_norm': gain((L, DIFF_QK)),
        'diff_k_norm': gain((L, DIFF_QK)),
        'diff_lq1': small((L, DIFF_QK), 0.1),
        'diff_lk1': small((L, DIFF_QK), 0.1),
        'diff_lq2': small((L, DIFF_QK), 0.1),
        'diff_lk2': small((L, DIFF_QK), 0.1),
        'diff_subln': gain((L, DIFF_V)),
        'nsa_q_norm': gain((L, NSA_D)),
        'nsa_pe_k': small((L, NSA_CMP_LEN, NSA_D), 0.1),
        'nsa_w_ck': dense((L, NSA_CMP_LEN * NSA_D, NSA_D), NSA_CMP_LEN * NSA_D),
        'nsa_pe_v': small((L, NSA_CMP_LEN, NSA_D), 0.1),
        'nsa_w_cv': dense((L, NSA_CMP_LEN * NSA_D, NSA_D), NSA_CMP_LEN * NSA_D),
        'nsa_kc_norm': gain((L, NSA_D)),
        'nsa_ks_norm': gain((L, NSA_D)),
        'nsa_kw_norm': gain((L, NSA_D)),
        'nsa_o_norm': gain((L, NSA_D)),
        'sb_o_norm': gain((L, SB_D)),
        'w_out': dense((L, MIX_WIDTH, D), MIX_WIDTH),
        'ffn2_norm': gain((L, D)),
        'ffn2_w_gate': dense((L, D, F), D),
        'ffn2_w_up': dense((L, D, F), D),
        'ffn2_w_down': dense((L, F, D), F),
    }


def reference(x, ffn1_norm, ffn1_w_gate, ffn1_w_up, ffn1_w_down, mix_norm, w_in,
              mla_cq_norm, mla_ckv_norm, mla_w_uq, mla_w_ukv, mla_qn_norm, mla_qr_norm,
              mla_kn_norm, mla_kr_norm, mla_o_norm,
              diff_q_norm, diff_k_norm, diff_lq1, diff_lk1, diff_lq2, diff_lk2, diff_subln,
              nsa_q_norm, nsa_pe_k, nsa_w_ck, nsa_pe_v, nsa_w_cv, nsa_kc_norm, nsa_ks_norm,
              nsa_kw_norm, nsa_o_norm, sb_o_norm, w_out,
              ffn2_norm, ffn2_w_gate, ffn2_w_up, ffn2_w_down):
    s = x.shape[1]
    pos = jnp.arange(s, dtype=jnp.float32)
    inv_freq = ROPE_THETA ** (-jnp.arange(0, MLA_ROPE, 2, dtype=jnp.float32) / MLA_ROPE)
    ang = pos[:, None] * inv_freq[None, :]
    cos, sin = jnp.cos(ang), jnp.sin(ang)
    slopes = _alibi_slopes(N_ALIBI_HEADS)
    diff_slopes, nsa_slopes = slopes[0::2], slopes[1::2]
    offsets = _in_offsets()

    h = x
    for l in range(DEPTH):
        h = h + 0.5 * _swiglu(_rms(h, ffn1_norm[l]), ffn1_w_gate[l], ffn1_w_up[l], ffn1_w_down[l])
        u = _rms(h, mix_norm[l]) @ w_in[l]
        (a_cq, a_ckv, a_kr, b_q, b_k, b_v, c_q, c_kc, c_vc, c_ks, c_vs, c_kw, c_vw, c_g,
         d_q, d_k, d_v) = jnp.split(u, offsets, axis=-1)
        lambda_init = 0.8 - 0.6 * math.exp(-0.3 * l)
        o_a = _mla(a_cq, a_ckv, a_kr, mla_cq_norm[l], mla_ckv_norm[l], mla_w_uq[l], mla_w_ukv[l],
                   mla_qn_norm[l], mla_qr_norm[l], mla_kn_norm[l], mla_kr_norm[l], mla_o_norm[l], cos, sin)
        o_b = _diff(b_q, b_k, b_v, diff_q_norm[l], diff_k_norm[l], diff_lq1[l], diff_lk1[l],
                    diff_lq2[l], diff_lk2[l], diff_subln[l], diff_slopes, lambda_init)
        o_c = _nsa(c_q, c_kc, c_vc, c_ks, c_vs, c_kw, c_vw, c_g, nsa_q_norm[l], nsa_pe_k[l], nsa_w_ck[l],
                   nsa_pe_v[l], nsa_w_cv[l], nsa_kc_norm[l], nsa_ks_norm[l], nsa_kw_norm[l],
                   nsa_o_norm[l], nsa_slopes)
        o_d = _stick_breaking(d_q, d_k, d_v, sb_o_norm[l])
        h = h + jnp.concatenate([o_a, o_b, o_c, o_d], axis=-1) @ w_out[l]
        h = h + 0.5 * _swiglu(_rms(h, ffn2_norm[l]), ffn2_w_gate[l], ffn2_w_up[l], ffn2_w_down[l])
    return h
```

```cpp
#include <hip/hip_runtime.h>
#include <hip/hip_cooperative_groups.h>
#include <cstdio>
#include <cstdint>
#include <cmath>
namespace cg = cooperative_groups;
namespace pg8 {
#define PG8_LAS __attribute__((address_space(3)))
typedef unsigned short bf16_t;
typedef short bf16x8 __attribute__((ext_vector_type(8)));
typedef float f32x4 __attribute__((ext_vector_type(4)));
typedef unsigned u32x4 __attribute__((ext_vector_type(4)));
constexpr int BM = 256, BK = 64, HALF = 128, HTB = HALF * BK * 2  , STAGE_BYTES = 8 * HTB, NXCD = 8, WGM = 8;

__host__ __device__ __forceinline__ int lds_byte(int r, int c) { const int st = (r >> 4) * 2 + (c >> 5), rr = r & 15, cc = c & 31, ob = rr * 64 + cc * 2; return st * 1024 + (ob ^ (((ob >> 9) & 1) << 5)); }
__host__ __device__ __forceinline__ void stage_rc(int b, int& R, int& C) { const int st = b / 1024, sb = b % 1024, swz = sb ^ (((sb >> 9) & 1) << 5); R = (st >> 1) * 16 + swz / 64; C = (st & 1) * 32 + (swz % 64) / 2; }
__host__ __device__ __forceinline__ int perm32(int rho) { const int n = rho >> 4, i = rho & 15; return 8 * (i >> 2) + 4 * n + (i & 3); }

struct Unit { int pm, pn; };
struct Gemm { const bf16_t* A; const bf16_t* Bt; int M, N, K, lda, ldb; };

struct StaticOrder {
    int nM, nN, nwg, G, c;
    __host__ __device__ void init(int M, int N, int G_, int c_) { nM = M / BM; nN = N / BM; nwg = nM * nN; G = G_; c = c_; }
    __host__ __device__ bool next(int i, Unit& u) const {
        const long L = (long)i * G + c; if (L >= nwg) return false;
        int wgid = (int)L; { const int q = nwg / NXCD, r = nwg % NXCD, xcd = wgid % NXCD, off = wgid / NXCD; wgid = (xcd < r ? xcd * (q + 1) : r * (q + 1) + (xcd - r) * q) + off; }
        const int nig = WGM * nN, gid = wgid / nig, fm = gid * WGM, gsz = (nM - fm) < WGM ? (nM - fm) : WGM;
        u.pm = fm + ((wgid % nig) % gsz); u.pn = (wgid % nig) / gsz; return true;
    }
    __device__ __forceinline__ void a_ready(const Unit&) const {}
    __device__ __forceinline__ void done(const Unit&) const {}
};

__device__ __forceinline__ unsigned cvt_pk_bf16(float lo, float hi) { unsigned r; asm volatile("v_cvt_pk_bf16_f32 %0, %1, %2" : "=v"(r) : "v"(lo), "v"(hi)); return r; }
typedef float f32x2 __attribute__((ext_vector_type(2)));
struct EpiStoreBf16 {
    static constexpr bool PERM = true, AFTER_DRAIN = false;
    bf16_t* O; int ldc; int ncols;
    __device__ __forceinline__ void operator()(const f32x4 (&acc)[2][2][4][2], const Unit& u, int wr, int wc, int fr, int fq) const {
        const int row0 = u.pm * BM + wr * 64 + fr; const int col0 = u.pn * BM + wc * 32 + 8 * fq;
#pragma unroll
        for (int ai = 0; ai < 2; ++ai)
#pragma unroll
            for (int m = 0; m < 4; ++m) { bf16_t* rowp = O + (size_t)(row0 + ai * HALF + m * 16) * ldc;
#pragma unroll
                for (int bj = 0; bj < 2; ++bj) { const int c = col0 + bj * HALF;
                    if (c < ncols) { const f32x4 v0 = acc[ai][bj][m][0], v1 = acc[ai][bj][m][1]; u32x4 w;
                        w.x = cvt_pk_bf16(v0[0], v0[1]); w.y = cvt_pk_bf16(v0[2], v0[3]); w.z = cvt_pk_bf16(v1[0], v1[1]); w.w = cvt_pk_bf16(v1[2], v1[3]);
                        *(u32x4*)(rowp + c) = w; } } }
    }
};
struct EpiSwiGLU {
    static constexpr bool PERM = true, AFTER_DRAIN = false;
    bf16_t* H; int ldc;
    __device__ __forceinline__ void operator()(const f32x4 (&acc)[2][2][4][2], const Unit& u, int wr, int wc, int fr, int fq) const {
        const int row0 = u.pm * BM + wr * 64 + fr; const int col0 = u.pn * HALF + wc * 32 + 8 * fq;
#pragma unroll
        for (int ai = 0; ai < 2; ++ai)
#pragma unroll
            for (int m = 0; m < 4; ++m) { bf16_t* rowp = H + (size_t)(row0 + ai * HALF + m * 16) * ldc + col0;
                float r[8];
#pragma unroll
                for (int n = 0; n < 2; ++n)
#pragma unroll
                    for (int e = 0; e < 4; ++e) { const float g = acc[ai][0][m][n][e], up = acc[ai][1][m][n][e];
                        r[n * 4 + e] = g * up * __builtin_amdgcn_rcpf(1.0f + __expf(-g)); }
                u32x4 w; w.x = cvt_pk_bf16(r[0], r[1]); w.y = cvt_pk_bf16(r[2], r[3]); w.z = cvt_pk_bf16(r[4], r[5]); w.w = cvt_pk_bf16(r[6], r[7]);
                *(u32x4*)rowp = w; }
    }
};
struct EpiResid {
    static constexpr bool PERM = false, AFTER_DRAIN = false;
    const float* base; float* out; int ldc; float alpha;
    __device__ __forceinline__ void operator()(const f32x4 (&acc)[2][2][4][2], const Unit& u, int wr, int wc, int fr, int fq) const {
        const int row0 = u.pm * BM + wr * 64 + fr; const int col0 = u.pn * BM + wc * 32 + 4 * fq;
#pragma unroll
        for (int ai = 0; ai < 2; ++ai)
#pragma unroll
            for (int m = 0; m < 4; ++m) { const size_t off = (size_t)(row0 + ai * HALF + m * 16) * ldc + col0;
#pragma unroll
                for (int bj = 0; bj < 2; ++bj)
#pragma unroll
                    for (int n = 0; n < 2; ++n) { const f32x4 b = *(const f32x4*)(base + off + bj * HALF + n * 16);
                        *(f32x4*)(out + off + bj * HALF + n * 16) = b + acc[ai][bj][m][n] * alpha; } }
    }
};

struct EpiStoreF32 {
    static constexpr bool PERM = true, AFTER_DRAIN = false;
    float* P; int ldc; int ncols;
    __device__ __forceinline__ void operator()(const f32x4 (&acc)[2][2][4][2], const Unit& u, int wr, int wc, int fr, int fq) const {
        const int row0 = u.pm * BM + wr * 64 + fr; const int col0 = u.pn * BM + wc * 32 + 8 * fq;
#pragma unroll
        for (int ai = 0; ai < 2; ++ai)
#pragma unroll
            for (int m = 0; m < 4; ++m) { float* rowp = P + (size_t)(row0 + ai * HALF + m * 16) * ldc;
#pragma unroll
                for (int bj = 0; bj < 2; ++bj) { const int c = col0 + bj * HALF;
                    if (c < ncols) { *(f32x4*)(rowp + c) = acc[ai][bj][m][0]; *(f32x4*)(rowp + c + 4) = acc[ai][bj][m][1]; } } }
    }
};
struct EpiAny {
    static constexpr bool AFTER_DRAIN = false;
    int mode; bf16_t* O; int ldc; int ncols; const float* base; float* out; float alpha;
    __device__ __forceinline__ bool perm() const { return mode != 2; }
    __device__ __forceinline__ void operator()(const f32x4 (&acc)[2][2][4][2], const Unit& u, int wr, int wc, int fr, int fq) const {
#ifndef NO_E0
        if (mode == 0) { EpiStoreBf16 e{O, ldc, ncols}; e(acc, u, wr, wc, fr, fq); }
#endif
#ifndef NO_E1
        if (mode == 1) { EpiSwiGLU e{O, ldc}; e(acc, u, wr, wc, fr, fq); }
#endif
#ifndef NO_E2
        if (mode == 2) { EpiResid e{base, out, ldc, alpha}; e(acc, u, wr, wc, fr, fq); }
#endif
        if (mode == 3) { EpiStoreF32 e{out, ldc, ncols}; e(acc, u, wr, wc, fr, fq); }
    }
};
template <class Epi, class Sched, bool ALIGN_EPI = false, bool SP2 = false>
__device__ __forceinline__ void gemm_phase(PG8_LAS unsigned char* lds, const Gemm g, const Sched& S, const Epi& E) {
    int tid = threadIdx.x; asm volatile("" : "+v"(tid)); const int wid = __builtin_amdgcn_readfirstlane(tid >> 6), lane = tid & 63, wr = wid >> 2, wc = wid & 3, fr = lane & 15, fq = lane >> 4;
    const int K = g.K, nt = K / BK;
    unsigned voffA[2], voffB[2];
#pragma unroll
    for (int i = 0; i < 2; ++i) { int R, C; stage_rc(tid * 16 + i * 8192, R, C); const int Rb = E.perm() ? ((R & ~31) + perm32(R & 31)) : R;
        voffA[i] = (unsigned)(R * g.lda + C) * 2u; voffB[i] = (unsigned)(Rb * g.ldb + C) * 2u; }
    const size_t kstep = (size_t)(BK * 2);
    const size_t hstep = (size_t)HALF * g.ldb * 2;
    const size_t tstep = 2 * hstep; const size_t hstepA = (size_t)HALF * g.lda * 2, tstepA = 2 * hstepA;
    const unsigned ldsw = (unsigned)wid * 1024u;
    const int aoff = lds_byte(wr * 64 + fr, fq * 8), boff = lds_byte(wc * 32 + fr, fq * 8);
#define PG8_SA(b, h) (((b) * 2 + (h)) * HTB)
#define PG8_SB(b, h) ((4 + (b) * 2 + (h)) * HTB)
#define PG8_STAGE(bufoff, gbase, voff) do { _Pragma("unroll") for (int _i = 0; _i < 2; ++_i) \
        __builtin_amdgcn_global_load_lds((const unsigned*)((const char*)(gbase) + (voff)[_i]), (PG8_LAS unsigned*)(lds + (bufoff) + ldsw + _i * 8192), 16, 0, 0); } while (0)
#define PG8_LDA(dst, b, h) do { _Pragma("unroll") for (int m = 0; m < 4; ++m) _Pragma("unroll") for (int k = 0; k < 2; ++k) dst[m][k] = *(const PG8_LAS bf16x8*)(lds + PG8_SA(b, h) + aoff + m * 2048 + k * 1024); } while (0)
#define PG8_LDB(dst, b, h) do { _Pragma("unroll") for (int n = 0; n < 2; ++n) _Pragma("unroll") for (int k = 0; k < 2; ++k) dst[n][k] = *(const PG8_LAS bf16x8*)(lds + PG8_SB(b, h) + boff + n * 2048 + k * 1024); } while (0)
#define PG8_MMA(ai, bj, At, Bt) do { __builtin_amdgcn_s_setprio(1); _Pragma("unroll") for (int m = 0; m < 4; ++m) _Pragma("unroll") for (int n = 0; n < 2; ++n) _Pragma("unroll") for (int k = 0; k < 2; ++k) \
        acc[ai][bj][m][n] = __builtin_amdgcn_mfma_f32_16x16x32_bf16(Bt[n][k], At[m][k], acc[ai][bj][m][n], 0, 0, 0); __builtin_amdgcn_s_setprio(0); } while (0)
#define PG8_WAIT_V(n) asm volatile("s_waitcnt vmcnt(" #n ")" ::: "memory")
#define PG8_WAIT_L(n) asm volatile("s_waitcnt lgkmcnt(" #n ")" ::: "memory")
#define PG8_BAR __builtin_amdgcn_s_barrier()
#define PG8_SCHED __builtin_amdgcn_sched_barrier(0)
    Unit cur, nxt; int ui = 0;
    if (!S.next(0, cur)) return;
    f32x4 acc[2][2][4][2];
#pragma unroll
    for (int a = 0; a < 2; ++a)
#pragma unroll
        for (int b = 0; b < 2; ++b)
#pragma unroll
            for (int m = 0; m < 4; ++m)
#pragma unroll
                for (int n = 0; n < 2; ++n) acc[a][b][m][n] = (f32x4){0.f, 0.f, 0.f, 0.f};
    bf16x8 At[4][2], B0[2][2], B1[2][2];
    const char* cA = (const char*)g.A + (size_t)cur.pm * tstepA; const char* cB = (const char*)g.Bt + (size_t)cur.pn * tstep;
    S.a_ready(cur);
    if constexpr (SP2) {
        PG8_STAGE(PG8_SB(0, 0), cB, voffB); PG8_STAGE(PG8_SB(0, 1), cB + hstep, voffB); PG8_STAGE(PG8_SA(0, 0), cA, voffA); PG8_STAGE(PG8_SA(0, 1), cA + hstepA, voffA);
        if (wr == 1) PG8_BAR;
        PG8_WAIT_V(2); PG8_BAR;
        PG8_STAGE(PG8_SB(1, 0), cB + kstep, voffB); PG8_STAGE(PG8_SA(1, 0), cA + kstep, voffA); PG8_STAGE(PG8_SB(1, 1), cB + hstep + kstep, voffB);
        PG8_WAIT_V(6); PG8_BAR;
    } else {
        PG8_STAGE(PG8_SB(0, 0), cB, voffB); PG8_STAGE(PG8_SA(0, 0), cA, voffA); PG8_STAGE(PG8_SB(0, 1), cB + hstep, voffB); PG8_STAGE(PG8_SA(0, 1), cA + hstepA, voffA);
        if (wr == 1) PG8_BAR;
        PG8_WAIT_V(4); PG8_BAR;
        PG8_STAGE(PG8_SB(1, 0), cB + kstep, voffB); PG8_STAGE(PG8_SA(1, 0), cA + kstep, voffA); PG8_STAGE(PG8_SB(1, 1), cB + hstep + kstep, voffB);
        PG8_WAIT_V(6); PG8_BAR;
    }
    for (;;) {
        const bool has_next = S.next(ui + 1, nxt);
        const char* nA = has_next ? (const char*)g.A + (size_t)nxt.pm * tstepA : cA; const char* nB = has_next ? (const char*)g.Bt + (size_t)nxt.pn * tstep : cB;
        for (int t = 0; t < nt; t += 2) {
            const bool last = (t == nt - 2);
            const char* a1 = cA + (size_t)(t + 1) * kstep;
            const char* a2 = last ? nA : cA + (size_t)(t + 2) * kstep; const char* b2 = last ? nB : cB + (size_t)(t + 2) * kstep;
            const char* a3 = a2 + kstep; const char* b3 = b2 + kstep;
            if (last && has_next) S.a_ready(nxt);
            if constexpr (SP2) {
            PG8_LDB(B0, 0, 0); PG8_LDB(B1, 0, 1); PG8_SCHED; PG8_LDA(At, 0, 0); PG8_STAGE(PG8_SA(1, 1), a1 + hstepA, voffA);
            PG8_WAIT_V(8); PG8_WAIT_L(0); PG8_BAR; PG8_MMA(0, 0, At, B0); PG8_MMA(0, 1, At, B1); PG8_BAR; PG8_SCHED;
            PG8_LDA(At, 0, 1); PG8_STAGE(PG8_SB(0, 0), b2, voffB); PG8_STAGE(PG8_SB(0, 1), b2 + hstep, voffB); PG8_STAGE(PG8_SA(0, 0), a2, voffA);
            PG8_WAIT_V(8); PG8_WAIT_L(0); PG8_BAR; PG8_MMA(1, 0, At, B0); PG8_MMA(1, 1, At, B1); PG8_BAR; PG8_SCHED;
            PG8_LDB(B0, 1, 0); PG8_LDB(B1, 1, 1); PG8_SCHED; PG8_LDA(At, 1, 0); PG8_STAGE(PG8_SA(0, 1), a2 + hstepA, voffA);
            PG8_WAIT_V(8); PG8_WAIT_L(0); PG8_BAR; PG8_MMA(0, 0, At, B0); PG8_MMA(0, 1, At, B1); PG8_BAR; PG8_SCHED;
            PG8_LDA(At, 1, 1); PG8_STAGE(PG8_SB(1, 0), b3, voffB); PG8_STAGE(PG8_SB(1, 1), b3 + hstep, voffB); PG8_STAGE(PG8_SA(1, 0), a3, voffA);
            PG8_WAIT_V(8); PG8_WAIT_L(0); PG8_BAR; PG8_MMA(1, 0, At, B0); PG8_MMA(1, 1, At, B1); PG8_BAR; PG8_SCHED;
            } else {
            PG8_LDB(B0, 0, 0); PG8_SCHED; PG8_LDA(At, 0, 0); PG8_STAGE(PG8_SA(1, 1), a1 + hstepA, voffA);
            PG8_WAIT_L(8); PG8_BAR; PG8_WAIT_L(0); PG8_MMA(0, 0, At, B0); PG8_BAR; PG8_SCHED;
            PG8_LDB(B1, 0, 1); PG8_STAGE(PG8_SB(0, 0), b2, voffB);
            PG8_BAR; PG8_WAIT_L(0); PG8_MMA(0, 1, At, B1); PG8_BAR;
            PG8_LDA(At, 0, 1); PG8_STAGE(PG8_SA(0, 0), a2, voffA);
            PG8_BAR; PG8_WAIT_L(0); PG8_MMA(1, 0, At, B0); PG8_BAR; PG8_SCHED;
            PG8_STAGE(PG8_SB(0, 1), b2 + hstep, voffB);
            PG8_WAIT_V(6); PG8_BAR; PG8_MMA(1, 1, At, B1); PG8_BAR;
            PG8_LDB(B0, 1, 0); PG8_SCHED; PG8_LDA(At, 1, 0); PG8_STAGE(PG8_SA(0, 1), a2 + hstepA, voffA);
            PG8_WAIT_L(8); PG8_BAR; PG8_WAIT_L(0); PG8_MMA(0, 0, At, B0); PG8_BAR; PG8_SCHED;
            PG8_LDB(B1, 1, 1); PG8_STAGE(PG8_SB(1, 0), b3, voffB);
            PG8_BAR; PG8_WAIT_L(0); PG8_MMA(0, 1, At, B1); PG8_BAR;
            PG8_LDA(At, 1, 1); PG8_STAGE(PG8_SA(1, 0), a3, voffA);
            PG8_BAR; PG8_WAIT_L(0); PG8_MMA(1, 0, At, B0); PG8_BAR; PG8_SCHED;
            PG8_STAGE(PG8_SB(1, 1), b3 + hstep, voffB);
            PG8_WAIT_V(6); PG8_BAR; PG8_MMA(1, 1, At, B1); PG8_BAR;
            }
        }
        if constexpr (ALIGN_EPI) { if (wr == 0) PG8_BAR; }
        if constexpr (!Epi::AFTER_DRAIN) { E(acc, cur, wr, wc, fr, fq); S.done(cur); }
        if (!has_next) break;
#pragma unroll
        for (int a = 0; a < 2; ++a)
#pragma unroll
            for (int b = 0; b < 2; ++b)
#pragma unroll
                for (int m = 0; m < 4; ++m)
#pragma unroll
                    for (int n = 0; n < 2; ++n) acc[a][b][m][n] = (f32x4){0.f, 0.f, 0.f, 0.f};
        cur = nxt; cA = nA; cB = nB; ++ui;
        if constexpr (ALIGN_EPI) { if (wr == 1) PG8_BAR; }
    }
    PG8_WAIT_V(0);
    if constexpr (!ALIGN_EPI) { if (wr == 0) PG8_BAR; }
    PG8_BAR;
    if constexpr (Epi::AFTER_DRAIN) { E.fused(acc, cur, wr, wc, fr, fq, lds, wid, lane); S.done(cur); }
#undef PG8_SA
#undef PG8_SB
#undef PG8_STAGE
#undef PG8_LDA
#undef PG8_LDB
#undef PG8_MMA
#undef PG8_WAIT_V
#undef PG8_WAIT_L
#undef PG8_BAR
#undef PG8_SCHED
}
}

#define DI __device__ __forceinline__
#define LAS __attribute__((address_space(3)))
typedef unsigned short bf16_t;
typedef short bf16x8 __attribute__((ext_vector_type(8)));
typedef short s16x4 __attribute__((ext_vector_type(4)));
typedef float f32x4 __attribute__((ext_vector_type(4)));
typedef float f32x16 __attribute__((ext_vector_type(16)));
typedef unsigned u32x4 __attribute__((ext_vector_type(4)));
typedef unsigned u32x2 __attribute__((ext_vector_type(2)));

constexpr int NTOK = 16384, SEQ = 4096, DM = 2048, DFF = 5632, NU = 5376  , NLAYER = 2;
constexpr float EPS = 1e-6f, LOG2E = 1.4426950408889634f;
constexpr int U_CQ = 0, U_CKV = 512, U_KR = 768, U_DQ = 832, U_DK = 1344, U_DV = 1856, U_NQ = 2368, U_KC = 2880, U_VC = 3008, U_KS = 3136, U_VS = 3264,
              U_KW = 3392, U_VW = 3520, U_SQ = 3648, U_SK = 4160, U_SV = 4672, U_G = 5184;
constexpr size_t MiB = 1u << 20;
constexpr size_t W_GU1 = 0, W_D1 = 44 * MiB, W_IN = 66 * MiB, W_UQ = 87 * MiB, W_UKV = 88 * MiB, W_CK = 89 * MiB, W_CV = 90 * MiB, W_OUT = 92 * MiB, W_GU2 = 100 * MiB,
                 W_D2 = 144 * MiB, W_LAYER = 166 * MiB;
constexpr size_t WS_CTL = 0, WS_W = 1 * MiB, WS_XN = WS_W + 2 * W_LAYER  , WS_HID = WS_XN + 64 * MiB  ,
                 WS_QM = WS_HID + 176 * MiB  , WS_KM = WS_QM + 24 * MiB, WS_KVR = WS_KM + 24 * MiB, WS_VTM = WS_KVR + 32 * MiB, WS_VTD = WS_VTM + 16 * MiB,
                 WS_VTS = WS_VTD + 16 * MiB, WS_VTVS = WS_VTS + 16 * MiB, WS_VTVW = WS_VTVS + 4 * MiB, WS_AK = WS_VTVW + 4 * MiB, WS_AV = WS_AK + 8 * MiB,
                 WS_KC = WS_AV + 9 * MiB, WS_VCR = WS_KC + 1 * MiB, WS_VTVC = WS_VCR + 1 * MiB, WS_STASH = WS_VTVC + 1 * MiB  , WS_END = WS_STASH + 32 * MiB;
static_assert(WS_END + 8 * MiB <= 770 * MiB, "workspace map");

DI float bf2f(unsigned b) { return __uint_as_float(b << 16); }
typedef float f32x2_t __attribute__((ext_vector_type(2))); typedef __bf16 bf16x2_t __attribute__((ext_vector_type(2)));
DI unsigned pk2(float lo, float hi) { f32x2_t v = {lo, hi}; bf16x2_t b = __builtin_convertvector(v, bf16x2_t); return __builtin_bit_cast(unsigned, b); }
DI float wave_sum(float v) {
#pragma unroll
    for (int o = 1; o < 64; o <<= 1) v += __shfl_xor(v, o);
    return v; }
template <int W> DI float grp_sum(float v) {
#pragma unroll
    for (int o = 1; o < W; o <<= 1) v += __shfl_xor(v, o);
    return v; }
DI void ld8(const bf16_t* p, float (&f)[8]) { const u32x4 v = *(const u32x4*)p;
    f[0] = bf2f(v.x & 0xffffu); f[1] = bf2f(v.x >> 16); f[2] = bf2f(v.y & 0xffffu); f[3] = bf2f(v.y >> 16);
    f[4] = bf2f(v.z & 0xffffu); f[5] = bf2f(v.z >> 16); f[6] = bf2f(v.w & 0xffffu); f[7] = bf2f(v.w >> 16); }
DI void st8(bf16_t* p, const float (&f)[8]) { u32x4 w; w.x = pk2(f[0], f[1]); w.y = pk2(f[2], f[3]); w.z = pk2(f[4], f[5]); w.w = pk2(f[6], f[7]); *(u32x4*)p = w; }
DI float ssq8(const float (&f)[8]) { float s = 0.f;
#pragma unroll
    for (int e = 0; e < 8; ++e) s += f[e] * f[e];
    return s; }
DI int otid() { int t = (int)threadIdx.x; asm volatile("" : "+v"(t)); return t; }
#define LDS_WAIT() asm volatile("s_waitcnt lgkmcnt(0)" ::: "memory")

struct Args { const float* in[38]; float* out; unsigned char* ws; float inv_freq[32]; int ph_lo, ph_hi; };

struct Ctx {
    int layer; const Args* a; unsigned char* ws;
    DI unsigned char* wl() const { return ws + WS_W + (size_t)layer * W_LAYER; }
#define CTX_PTR(name, off) DI bf16_t* name() const { return (bf16_t*)(ws + (off)); }
    CTX_PTR(XN, WS_XN) CTX_PTR(MIX, WS_XN) CTX_PTR(HID, WS_HID) CTX_PTR(U, WS_HID) CTX_PTR(QM, WS_QM) CTX_PTR(KM, WS_KM) CTX_PTR(KVR, WS_KVR) CTX_PTR(VTM, WS_VTM)
    CTX_PTR(VTD, WS_VTD) CTX_PTR(VTS, WS_VTS) CTX_PTR(VTVS, WS_VTVS) CTX_PTR(VTVW, WS_VTVW) CTX_PTR(AK, WS_AK) CTX_PTR(AV, WS_AV) CTX_PTR(KC, WS_KC) CTX_PTR(VCR, WS_VCR)
    CTX_PTR(VTVC, WS_VTVC)
    DI float* PART() const { return (float*)(ws + WS_END); }
#undef CTX_PTR
};
DI Ctx make_ctx(const Args& a, int layer) { Ctx c; c.layer = layer; c.a = &a; c.ws = a.ws; return c; }

struct WDesc { const float* W; const float* gain; bf16_t* WT; int K, N, mode; float cscale; };
DI int wt_out_row(int mode, int c) {
    if (mode == 1) return 256 * (c >> 7) + (c & 127);
    if (mode == 2) return 256 * (c >> 7) + 128 + (c & 127);
    if (mode == 3) return c < 3648 ? c : (c < 3660 ? U_G + (c - 3648) : c - 12);
    return c;
}
DI void wt_item(const WDesc& d, LAS float* scr, int item, int lane) {
    const int nblk = (d.N + 31) >> 5, kb = item / nblk, nb = item - kb * nblk, k0 = 64 * kb, n0 = 32 * nb;
    const int c = n0 + (lane & 31); const bool cv = c < d.N;
    float cs = 1.f; if (d.mode == 3 && c >= 3660 && c < 4172) cs = d.cscale;
    float wv[32];
    const float* wp = d.W + (size_t)(k0 + (lane >> 5)) * d.N + (cv ? c : 0);
#pragma unroll
    for (int i = 0; i < 32; ++i) wv[i] = wp[(size_t)(2 * i) * d.N];
#pragma unroll
    for (int i = 0; i < 32; ++i) { const int kk = 2 * i + (lane >> 5); float w = cv ? wv[i] : 0.f; if (d.gain) w *= d.gain[k0 + kk]; scr[kk * 33 + (lane & 31)] = w * cs; }
    LDS_WAIT();
    const int ch = lane & 7;
#pragma unroll
    for (int j = 0; j < 4; ++j) { const int n = (lane >> 3) + 8 * j; const int cc = n0 + n;
        if (cc < d.N) { const LAS float* s = scr + (8 * ch) * 33 + n; u32x4 o;
            o.x = pk2(s[0 * 33], s[1 * 33]); o.y = pk2(s[2 * 33], s[3 * 33]); o.z = pk2(s[4 * 33], s[5 * 33]); o.w = pk2(s[6 * 33], s[7 * 33]);
            *(u32x4*)(d.WT + (size_t)wt_out_row(d.mode, cc) * d.K + k0 + 8 * ch) = o; } }
    LDS_WAIT();
}
constexpr int WI_G = 32 * 176, WI_D = 88 * 64, WI_IN = 32 * 163, WI_UQ = 8 * 24, WI_UKV = 4 * 32, WI_C = 64 * 4, WI_OUT = 32 * 64;
constexpr int WI_LAYER = 6 * WI_G + WI_IN + WI_UQ + WI_UKV + 2 * WI_C + WI_OUT;
DI void p0_weights(const Args& a, LAS unsigned char* lds, int gw, int NGW, int wave, int lane) {
    LAS float* scr = (LAS float*)(lds + wave * 8704);
    for (int it = gw; it < NLAYER * WI_LAYER; it += NGW) {
        const int L = it / WI_LAYER; int r = it - L * WI_LAYER; unsigned char* wl = a.ws + WS_W + (size_t)L * W_LAYER;
        const size_t oDF = (size_t)L * DM * DFF, oD = (size_t)L * DM; WDesc d; d.cscale = 1.f; d.gain = nullptr;
        if (r < WI_G) { d = WDesc{a.in[2] + oDF, a.in[1] + oD, (bf16_t*)(wl + W_GU1), DM, DFF, 1, 1.f}; }
        else if ((r -= WI_G) < WI_G) { d = WDesc{a.in[3] + oDF, a.in[1] + oD, (bf16_t*)(wl + W_GU1), DM, DFF, 2, 1.f}; }
        else if ((r -= WI_G) < WI_D) { d = WDesc{a.in[4] + oDF, nullptr, (bf16_t*)(wl + W_D1), DFF, DM, 0, 1.f}; }
        else if ((r -= WI_D) < WI_IN) { d = WDesc{a.in[6] + (size_t)L * DM * 5196, a.in[5] + oD, (bf16_t*)(wl + W_IN), DM, 5196, 3, 0.08838834764831845f * LOG2E}; }
        else if ((r -= WI_IN) < WI_UQ) { d = WDesc{a.in[9] + (size_t)L * 512 * 768, a.in[7] + (size_t)L * 512, (bf16_t*)(wl + W_UQ), 512, 768, 0, 1.f}; }
        else if ((r -= WI_UQ) < WI_UKV) { d = WDesc{a.in[10] + (size_t)L * 256 * 1024, a.in[8] + (size_t)L * 256, (bf16_t*)(wl + W_UKV), 256, 1024, 0, 1.f}; }
        else if ((r -= WI_UKV) < WI_C) { d = WDesc{a.in[25] + (size_t)L * 4096 * 128, nullptr, (bf16_t*)(wl + W_CK), 4096, 128, 0, 1.f}; }
        else if ((r -= WI_C) < WI_C) { d = WDesc{a.in[27] + (size_t)L * 4096 * 128, nullptr, (bf16_t*)(wl + W_CV), 4096, 128, 0, 1.f}; }
        else if ((r -= WI_C) < WI_OUT) { d = WDesc{a.in[33] + (size_t)L * DM * DM, nullptr, (bf16_t*)(wl + W_OUT), DM, DM, 0, 1.f}; }
        else if ((r -= WI_OUT) < WI_G) { d = WDesc{a.in[35] + oDF, a.in[34] + oD, (bf16_t*)(wl + W_GU2), DM, DFF, 1, 1.f}; }
        else if ((r -= WI_G) < WI_G) { d = WDesc{a.in[36] + oDF, a.in[34] + oD, (bf16_t*)(wl + W_GU2), DM, DFF, 2, 1.f}; }
        else { r -= WI_G; d = WDesc{a.in[37] + oDF, nullptr, (bf16_t*)(wl + W_D2), DFF, DM, 0, 1.f}; }
        wt_item(d, scr, r, lane);
    }
}
DI void norm_rows(const float* src, bf16_t* xn, int gw, int NGW, int lane) {
    for (int m = gw; m < NTOK; m += NGW) {
        const f32x4* xr = (const f32x4*)(src + (size_t)m * DM) + lane; f32x4 v[8]; float s = 0.f;
#pragma unroll
        for (int j = 0; j < 8; ++j) { v[j] = xr[64 * j]; s += (v[j].x * v[j].x + v[j].y * v[j].y) + (v[j].z * v[j].z + v[j].w * v[j].w); }
        const float rstd = 1.0f / sqrtf(wave_sum(s) * (1.0f / DM) + EPS);
        u32x2* o = (u32x2*)(xn + (size_t)m * DM) + lane;
#pragma unroll
        for (int j = 0; j < 8; ++j) { u32x2 w; w.x = pk2(v[j].x * rstd, v[j].y * rstd); w.y = pk2(v[j].z * rstd, v[j].w * rstd); o[64 * j] = w; }
    }
}
DI void up8(const u32x4 v, float (&f)[8]) {
    f[0] = bf2f(v.x & 0xffffu); f[1] = bf2f(v.x >> 16); f[2] = bf2f(v.y & 0xffffu); f[3] = bf2f(v.y >> 16);
    f[4] = bf2f(v.z & 0xffffu); f[5] = bf2f(v.z >> 16); f[6] = bf2f(v.w & 0xffffu); f[7] = bf2f(v.w >> 16); }
DI void rope_cs(float ang, float& c, float& s) { const double rev = (double)ang * 0.15915494309189535; const float fr = (float)(rev - __builtin_rint(rev));
    s = __builtin_amdgcn_sinf(fr); c = __builtin_amdgcn_cosf(fr); }
DI void transpose64(const bf16_t* src_row, bf16_t* dst_lane, size_t dpitch) {
#pragma unroll
    for (int i = 0; i < 8; ++i) { const u32x4 v = *(const u32x4*)(src_row + 8 * i); bf16_t* d = dst_lane + (size_t)(8 * i) * dpitch;
        d[0] = (bf16_t)(v.x & 0xffffu); d[dpitch] = (bf16_t)(v.x >> 16); d[2 * dpitch] = (bf16_t)(v.y & 0xffffu); d[3 * dpitch] = (bf16_t)(v.y >> 16);
        d[4 * dpitch] = (bf16_t)(v.z & 0xffffu); d[5 * dpitch] = (bf16_t)(v.z >> 16); d[6 * dpitch] = (bf16_t)(v.w & 0xffffu); d[7 * dpitch] = (bf16_t)(v.w >> 16); }
}
DI void fix1(const Ctx& C, int gw, int NGW, int lane) {
    const Args& a = *C.a; const int L = C.layer;
    const float* kr_g = a.in[14] + L * 64; const float* dq_g = a.in[16] + L * 64; const float* dk_g = a.in[17] + L * 64; const float* nq_g = a.in[23] + L * 128;
    const float* pe_k = a.in[24] + L * 4096; const float* pe_v = a.in[26] + L * 4096; const float* ks_g = a.in[29] + L * 128; const float* kw_g = a.in[30] + L * 128;
    for (int m = gw; m < NTOK; m += NGW) {
        bf16_t* ur = C.U() + (size_t)m * NU; const int b = m >> 12, s = m & 4095; float f[8];
        const int off_kv = lane < 32 ? U_CKV + 8 * lane : U_KR + 8 * (lane & 7);
        const int off_ms = ((lane >> 4) == 0 ? U_KC : (lane >> 4) == 1 ? U_VC : (lane >> 4) == 2 ? U_KS : U_KW) + 8 * (lane & 15);
        const u32x4 r_cq = *(const u32x4*)(ur + U_CQ + 8 * lane), r_kv = *(const u32x4*)(ur + off_kv), r_dq = *(const u32x4*)(ur + U_DQ + 8 * lane),
                    r_dk = *(const u32x4*)(ur + U_DK + 8 * lane), r_nq = *(const u32x4*)(ur + U_NQ + 8 * lane), r_ms = *(const u32x4*)(ur + off_ms);
        { up8(r_cq, f); const float rstd = 1.0f / sqrtf(wave_sum(ssq8(f)) * (1.0f / 512) + EPS);
#pragma unroll
          for (int e = 0; e < 8; ++e) f[e] *= rstd;
          st8(ur + U_CQ + 8 * lane, f); }
        { const int off = off_kv; up8(r_kv, f); const float q = ssq8(f);
          const float tot = wave_sum(lane < 32 ? q : 0.f); const float kq = grp_sum<8>(q);
          float y[8], yp[8];
          const int li = lane & 7;
#pragma unroll
          for (int e = 0; e < 8; ++e) { y[e] = f[e] * (1.0f / sqrtf(kq * (1.0f / 64) + EPS)) * kr_g[8 * li + e]; }
#pragma unroll
          for (int e = 0; e < 8; ++e) yp[e] = __shfl_xor(y[e], 4);
          if (lane < 32) { const float rstd = 1.0f / sqrtf(tot * (1.0f / 256) + EPS);
#pragma unroll
              for (int e = 0; e < 8; ++e) f[e] *= rstd;
              st8(ur + off, f);
          } else if (lane < 40) { float o[8];
#pragma unroll
              for (int e = 0; e < 8; ++e) { float cs, sn; rope_cs((float)s * a.inv_freq[8 * (li & 3) + e], cs, sn); o[e] = (li < 4) ? y[e] * cs - yp[e] * sn : y[e] * cs + yp[e] * sn; }
#pragma unroll
              for (int hh = 0; hh < 4; ++hh) st8(C.KM() + (size_t)m * 768 + hh * 192 + 128 + 8 * li, o); } }
        { up8(r_dq, f); const float rstd = 1.0f / sqrtf(grp_sum<8>(ssq8(f)) * (1.0f / 64) + EPS) * (0.125f * LOG2E);
#pragma unroll
          for (int e = 0; e < 8; ++e) f[e] *= rstd * dq_g[8 * (lane & 7) + e];
          st8(ur + U_DQ + 8 * lane, f);
          up8(r_dk, f); const float rstd2 = 1.0f / sqrtf(grp_sum<8>(ssq8(f)) * (1.0f / 64) + EPS);
#pragma unroll
          for (int e = 0; e < 8; ++e) f[e] *= rstd2 * dk_g[8 * (lane & 7) + e];
          st8(ur + U_DK + 8 * lane, f); }
        { up8(r_nq, f); const float rstd = 1.0f / sqrtf(grp_sum<16>(ssq8(f)) * (1.0f / 128) + EPS) * (0.08838834764831845f * LOG2E);
#pragma unroll
          for (int e = 0; e < 8; ++e) f[e] *= rstd * nq_g[8 * (lane & 15) + e];
          st8(ur + U_NQ + 8 * lane, f); }
        { const int grp = lane >> 4, d0 = 8 * (lane & 15); const int off = off_ms; up8(r_ms, f);
          const float q = grp_sum<16>(ssq8(f));
          if (grp >= 2) { const float* g = grp == 2 ? ks_g : kw_g; const float rstd = 1.0f / sqrtf(q * (1.0f / 128) + EPS);
#pragma unroll
              for (int e = 0; e < 8; ++e) f[e] *= rstd * g[d0 + e];
              st8(ur + off, f);
          } else { const float* pe = grp == 0 ? pe_k : pe_v; bf16_t* A = grp == 0 ? C.AK() : C.AV(); const int n1 = s >> 4, li = s & 15; float o[8];
              if (n1 == 255) {
#pragma unroll
                  for (int e = 0; e < 8; ++e) o[e] = 0.f;
                  st8(A + (size_t)(b * 256 + 255) * 4096 + li * 128 + d0, o); st8(A + (size_t)(b * 256 + 255) * 4096 + (li + 16) * 128 + d0, o);
              } else {
#pragma unroll
                  for (int e = 0; e < 8; ++e) o[e] = f[e] + pe[li * 128 + d0 + e];
                  st8(A + (size_t)(b * 256 + n1) * 4096 + li * 128 + d0, o); }
              if (n1 >= 1) {
#pragma unroll
                  for (int e = 0; e < 8; ++e) o[e] = f[e] + pe[(li + 16) * 128 + d0 + e];
                  st8(A + (size_t)(b * 256 + n1 - 1) * 4096 + (li + 16) * 128 + d0, o); } } }
    }
    for (int it = gw; it < 256 * 20; it += NGW) { const int tg = it / 20, ch = it - tg * 20; const int m = 64 * tg + lane, b = m >> 12, s = m & 4095;
        int col; bf16_t* dst;
        if (ch < 8) { col = U_DV + 64 * ch; dst = C.VTD() + ((size_t)(b * 4 + (ch >> 1)) * 128 + 64 * (ch & 1)) * SEQ; }
        else if (ch < 10) { col = U_VS + 64 * (ch - 8); dst = C.VTVS() + ((size_t)b * 128 + 64 * (ch - 8)) * SEQ; }
        else if (ch < 12) { col = U_VW + 64 * (ch - 10); dst = C.VTVW() + ((size_t)b * 128 + 64 * (ch - 10)) * SEQ; }
        else { const int c2 = ch - 12; col = U_SV + 64 * c2; dst = C.VTS() + ((size_t)(b * 4 + (c2 >> 1)) * 128 + 64 * (c2 & 1)) * SEQ; }
        transpose64(C.U() + (size_t)m * NU + col, dst + s, SEQ); }
}
DI void fix2(const Ctx& C, int gw, int NGW, int lane) {
    const Args& a = *C.a; const int L = C.layer;
    const float* qn_g = a.in[11] + L * 128; const float* qr_g = a.in[12] + L * 64; const float* kn_g = a.in[13] + L * 128; const float* kc_g = a.in[28] + L * 128;
    const float qscale = 0.07216878364870322f * LOG2E;
    for (int m = gw; m < NTOK; m += NGW) { const int s = m & 4095; float f[8];
        bf16_t* qr = C.QM() + (size_t)m * 768;
        const u32x4 r_qn = *(const u32x4*)(qr + (lane >> 4) * 192 + 8 * (lane & 15)), r_qr = *(const u32x4*)(qr + ((lane & 31) >> 3) * 192 + 128 + 8 * (lane & 7)),
                    r_kn = *(const u32x4*)(C.KVR() + (size_t)m * 1024 + (lane >> 4) * 256 + 8 * (lane & 15));
        { const int hd = lane >> 4, d0 = 8 * (lane & 15); up8(r_qn, f); const float rstd = 1.0f / sqrtf(grp_sum<16>(ssq8(f)) * (1.0f / 128) + EPS) * qscale;
#pragma unroll
          for (int e = 0; e < 8; ++e) f[e] *= rstd * qn_g[d0 + e];
          st8(qr + hd * 192 + d0, f); }
        { const int l5 = lane & 31, hd = l5 >> 3, li = l5 & 7; up8(r_qr, f); const float rstd = 1.0f / sqrtf(grp_sum<8>(ssq8(f)) * (1.0f / 64) + EPS);
          float y[8], yp[8], o[8];
#pragma unroll
          for (int e = 0; e < 8; ++e) y[e] = f[e] * rstd * qr_g[8 * li + e];
#pragma unroll
          for (int e = 0; e < 8; ++e) yp[e] = __shfl_xor(y[e], 4);
#pragma unroll
          for (int e = 0; e < 8; ++e) { float cs, sn; rope_cs((float)s * a.inv_freq[8 * (li & 3) + e], cs, sn); o[e] = ((li < 4) ? y[e] * cs - yp[e] * sn : y[e] * cs + yp[e] * sn) * qscale; }
          if (lane < 32) st8(qr + hd * 192 + 128 + 8 * li, o); }
        { const int hd = lane >> 4, d0 = 8 * (lane & 15); up8(r_kn, f); const float rstd = 1.0f / sqrtf(grp_sum<16>(ssq8(f)) * (1.0f / 128) + EPS);
#pragma unroll
          for (int e = 0; e < 8; ++e) f[e] *= rstd * kn_g[d0 + e];
          st8(C.KM() + (size_t)m * 768 + hd * 192 + d0, f); }
    }
    for (int r4 = gw; r4 < 256; r4 += NGW) { const int row = 4 * r4 + (lane >> 4), d0 = 8 * (lane & 15); float f[8];
#pragma unroll
        for (int e = 0; e < 8; ++e) f[e] = 0.f;
#pragma unroll
        for (int ks = 0; ks < 8; ++ks) { const f32x4* p = (const f32x4*)(C.PART() + ((size_t)ks * 1024 + row) * 128 + d0); const f32x4 a0 = p[0], a1 = p[1];
            f[0] += a0.x; f[1] += a0.y; f[2] += a0.z; f[3] += a0.w; f[4] += a1.x; f[5] += a1.y; f[6] += a1.z; f[7] += a1.w; }
        const float rstd = 1.0f / sqrtf(grp_sum<16>(ssq8(f)) * (1.0f / 128) + EPS);
#pragma unroll
        for (int e = 0; e < 8; ++e) f[e] *= rstd * kc_g[d0 + e];
        st8(C.KC() + (size_t)row * 128 + d0, f); }
    for (int it = gw; it < 256 * 8 + 32; it += NGW) {
        if (it < 2048) { const int tg = it >> 3, ch = it & 7; const int m = 64 * tg + lane, b = m >> 12, s = m & 4095;
            transpose64(C.KVR() + (size_t)m * 1024 + (ch >> 1) * 256 + 128 + 64 * (ch & 1), C.VTM() + ((size_t)(b * 4 + (ch >> 1)) * 128 + 64 * (ch & 1)) * SEQ + s, SEQ);
        } else { const int i2 = it - 2048, rg = i2 >> 1, ch = i2 & 1; const int row = 64 * rg + lane, b = row >> 8, n = row & 255;
            bf16_t* dst = C.VTVC() + ((size_t)b * 128 + 64 * ch) * 256 + n;
#pragma unroll 4
            for (int dq = 0; dq < 16; ++dq) { f32x4 s4 = {0.f, 0.f, 0.f, 0.f};
#pragma unroll
                for (int ks = 0; ks < 8; ++ks) s4 += *(const f32x4*)(C.PART() + ((size_t)(8 + ks) * 1024 + row) * 128 + 64 * ch + 4 * dq);
                dst[(size_t)(4 * dq) * 256] = (bf16_t)(pk2(s4.x, 0.f) & 0xffffu); dst[(size_t)(4 * dq + 1) * 256] = (bf16_t)(pk2(s4.y, 0.f) & 0xffffu);
                dst[(size_t)(4 * dq + 2) * 256] = (bf16_t)(pk2(s4.z, 0.f) & 0xffffu); dst[(size_t)(4 * dq + 3) * 256] = (bf16_t)(pk2(s4.w, 0.f) & 0xffffu); } }
    }
}

namespace att {
constexpr float NEG = -1e30f;
constexpr int VP = 72;
constexpr int OFF_K = 0, OFF_V = 25600, OFF_WS = OFF_V + 128 * VP * 2  , OFF_IMP = OFF_WS + 8 * 256  , OFF_SEL = OFF_IMP + 16384  ,
              OFF_MISC = OFF_SEL + 512  , LDS_END = OFF_MISC + 64;
DI int crow(int reg, int h) { return (reg & 3) + 8 * (reg >> 2) + 4 * h; }
#define MFMA32(a, b, c) __builtin_amdgcn_mfma_f32_32x32x16_bf16((a), (b), (c), 0, 0, 0)

struct Pre { u32x4 k[3]; u32x4 v[2]; };
template <int DK> DI void prefetch(int tid, Pre& P, const bf16_t* kg, size_t kpitch, const bf16_t* vg, size_t vpitch, bool with_v) {
    constexpr int PPR = DK / 8;
#pragma unroll
    for (int i = 0; i < (64 * PPR) / 512; ++i) { const int p = tid + i * 512; const int r = p / PPR, c = p - r * PPR; P.k[i] = *(const u32x4*)(kg + (size_t)r * kpitch + c * 8); }
    if (with_v) {
#pragma unroll
        for (int i = 0; i < 2; ++i) { const int p = tid + i * 512; const int r = p >> 3, c = p & 7; P.v[i] = *(const u32x4*)(vg + (size_t)r * vpitch + c * 8); } }
}
template <int DK> DI void commit(int tid, const Pre& P, LAS unsigned char* lds, bool with_v) {
    constexpr int PPR = DK / 8, KP = DK + 8;
#pragma unroll
    for (int i = 0; i < (64 * PPR) / 512; ++i) { const int p = tid + i * 512; const int r = p / PPR, c = p - r * PPR; *(LAS u32x4*)(lds + OFF_K + (r * KP + c * 8) * 2) = P.k[i]; }
    if (with_v) {
#pragma unroll
        for (int i = 0; i < 2; ++i) { const int p = tid + i * 512; const int r = p >> 3, c = p & 7; *(LAS u32x4*)(lds + OFF_V + (r * VP + c * 8) * 2) = P.v[i]; } }
}
template <int DK> DI void qk(f32x16& p0, f32x16& p1, const LAS unsigned char* lds, const bf16x8 (&qf)[DK / 16], int r, int h) {
    constexpr int KP = DK + 8;
    const LAS unsigned char* k0 = lds + OFF_K + (r * KP + 8 * h) * 2; const LAS unsigned char* k1 = k0 + 32 * KP * 2;
#pragma unroll
    for (int e = 0; e < 16; ++e) { p0[e] = 0.f; p1[e] = 0.f; }
#pragma unroll
    for (int ks = 0; ks < DK / 16; ++ks) { const bf16x8 a0 = *(const LAS bf16x8*)(k0 + ks * 32); const bf16x8 a1 = *(const LAS bf16x8*)(k1 + ks * 32);
        p0 = MFMA32(a0, qf[ks], p0); p1 = MFMA32(a1, qf[ks], p1); }
}
DI bf16x8 pack8(const f32x16& x, int s) {
    u32x4 p; p.x = pk2(x[8 * s], x[8 * s + 1]); p.y = pk2(x[8 * s + 2], x[8 * s + 3]); p.z = pk2(x[8 * s + 4], x[8 * s + 5]); p.w = pk2(x[8 * s + 6], x[8 * s + 7]);
    return __builtin_bit_cast(bf16x8, p); }
DI void pv(f32x16 (&o)[4], const f32x16& p0, const f32x16& p1, const LAS unsigned char* lds, int r, int h) {
    const LAS unsigned char* vb = lds + OFF_V + (r * VP + 4 * h) * 2;
#pragma unroll
    for (int sp = 0; sp < 4; ++sp) { const bf16x8 pa = (sp < 2) ? pack8(p0, sp & 1) : pack8(p1, sp & 1);
#pragma unroll
        for (int db = 0; db < 4; ++db) { const LAS unsigned char* vr = vb + db * 32 * VP * 2 + sp * 32;
            const s16x4 lo = *(const LAS s16x4*)(vr); const s16x4 hi = *(const LAS s16x4*)(vr + 16);
            const bf16x8 vv = __builtin_shufflevector(lo, hi, 0, 1, 2, 3, 4, 5, 6, 7);
            o[db] = MFMA32(pa, vv, o[db]); } }
}
DI void scale_rows(f32x16 (&o)[4], float fac, LAS float* wsf, int r, int h) {
    if (h == 0) wsf[r] = fac;
    LDS_WAIT(); __builtin_amdgcn_wave_barrier();
#pragma unroll
    for (int g = 0; g < 4; ++g) { const f32x4 f4 = *(const LAS f32x4*)(wsf + 8 * g + 4 * h);
#pragma unroll
        for (int db = 0; db < 4; ++db) { o[db][4 * g] *= f4.x; o[db][4 * g + 1] *= f4.y; o[db][4 * g + 2] *= f4.z; o[db][4 * g + 3] *= f4.w; } }
    LDS_WAIT(); __builtin_amdgcn_wave_barrier();
}
DI void stash_store(float* st, const f32x16 (&o)[4], int tid) { f32x4* p = (f32x4*)(st + tid * 64);
#pragma unroll
    for (int db = 0; db < 4; ++db)
#pragma unroll
        for (int g = 0; g < 4; ++g) p[db * 4 + g] = (f32x4){o[db][4 * g], o[db][4 * g + 1], o[db][4 * g + 2], o[db][4 * g + 3]}; }
DI void stash_add(const float* st, f32x16 (&o)[4], int tid) { const f32x4* p = (const f32x4*)(st + tid * 64);
#pragma unroll
    for (int db = 0; db < 4; ++db)
#pragma unroll
        for (int g = 0; g < 4; ++g) { const f32x4 v = p[db * 4 + g]; o[db][4 * g] += v.x; o[db][4 * g + 1] += v.y; o[db][4 * g + 2] += v.z; o[db][4 * g + 3] += v.w; } }
DI float max32(const f32x16& p0, const f32x16& p1) { float a = fmaxf(p0[0], p1[0]);
#pragma unroll
    for (int e = 1; e < 16; ++e) a = fmaxf(a, fmaxf(p0[e], p1[e]));
    return fmaxf(a, __shfl_xor(a, 32)); }
DI void softmax_step(f32x16& p0, f32x16& p1, float& m, float& l, f32x16 (&o)[4], LAS float* wsf, int r, int h, bool has_o) {
    const float mn = fmaxf(m, max32(p0, p1)); const float mu = (mn < 0.5f * NEG) ? 0.f : mn; const float f = __builtin_amdgcn_exp2f(m - mu);
    float s = 0.f;
#pragma unroll
    for (int e = 0; e < 16; ++e) { p0[e] = __builtin_amdgcn_exp2f(p0[e] - mu); p1[e] = __builtin_amdgcn_exp2f(p1[e] - mu); s += p0[e] + p1[e]; }
    l = l * f + s; m = mn;
    if (has_o && __any(f != 1.0f)) scale_rows(o, f, wsf, r, h);
}
DI void finish_write(const f32x16 (&o)[4], const float* gain, float extra, bf16_t* out, size_t pitch, int r, int h) {
    float g[4];
#pragma unroll
    for (int db = 0; db < 4; ++db) g[db] = gain[r + 32 * db] * extra;
#pragma unroll
    for (int reg = 0; reg < 16; ++reg) { float ss = o[0][reg] * o[0][reg] + o[1][reg] * o[1][reg] + o[2][reg] * o[2][reg] + o[3][reg] * o[3][reg];
        ss += __shfl_xor(ss, 1); ss += __shfl_xor(ss, 2); ss += __shfl_xor(ss, 4); ss += __shfl_xor(ss, 8); ss += __shfl_xor(ss, 16);
        const float rstd = 1.0f / sqrtf(ss * (1.0f / 128) + EPS); bf16_t* orow = out + (size_t)crow(reg, h) * pitch + r;
#pragma unroll
        for (int db = 0; db < 4; ++db) orow[32 * db] = (bf16_t)(pk2(o[db][reg] * rstd * g[db], 0.f) & 0xffffu); }
}
DI void zero_o(f32x16 (&o)[4]) {
#pragma unroll
    for (int db = 0; db < 4; ++db)
#pragma unroll
        for (int e = 0; e < 16; ++e) o[db][e] = 0.f; }
DI void bias_mask(f32x16& p0, f32x16& p1, int kv0, int t, int h, float slope2, bool do_mask) {
    const int d0 = kv0 + 4 * h - t;
#pragma unroll
    for (int e = 0; e < 16; ++e) { const int dk = d0 + (e & 3) + 8 * (e >> 2);
        p0[e] = fmaf(slope2, (float)dk, p0[e]); p1[e] = fmaf(slope2, (float)(dk + 32), p1[e]);
        if (do_mask) { if (dk > 0) p0[e] = NEG; if (dk + 32 > 0) p1[e] = NEG; } }
}

DI void unit_mla(LAS unsigned char* lds, const Ctx& C, int b, int hd, int qb) {
    const int tid = otid(), lane = tid & 63, w = __builtin_amdgcn_readfirstlane(tid >> 6), r = lane & 31, h = lane >> 5;
    LAS float* wsf = (LAS float*)(lds + OFF_WS + w * 256);
    const int t0 = qb * 256 + w * 32, t = t0 + r; const size_t tok = (size_t)b * SEQ + t;
    bf16x8 qf[12];
#pragma unroll
    for (int ks = 0; ks < 12; ++ks) qf[ks] = *(const bf16x8*)(C.QM() + tok * 768 + hd * 192 + 16 * ks + 8 * h);
    const bf16_t* kbase = C.KM() + (size_t)b * SEQ * 768 + hd * 192; const bf16_t* vbase = C.VTM() + (size_t)((b * 4 + hd) * 128) * SEQ;
    f32x16 o[4]; zero_o(o); float m = NEG, l = 0.f; const int nt = 4 * qb + 4;
    Pre P; prefetch<192>(tid, P, kbase, 768, vbase, SEQ, true);
    for (int j = 0; j < nt; ++j) {
        __syncthreads(); commit<192>(tid, P, lds, true); __syncthreads();
        if (j + 1 < nt) prefetch<192>(tid, P, kbase + (size_t)(j + 1) * 64 * 768, 768, vbase + (j + 1) * 64, SEQ, true);
        const int kv0 = 64 * j;
        if (kv0 <= t0 + 31) { f32x16 p0, p1; qk<192>(p0, p1, lds, qf, r, h);
            if (kv0 + 63 > t0) bias_mask(p0, p1, kv0, t, h, 0.f, true);
            softmax_step(p0, p1, m, l, o, wsf, r, h, true); pv(o, p0, p1, lds, r, h); }
    }
    l += __shfl_xor(l, 32); scale_rows(o, 1.0f / fmaxf(l, 1e-30f), wsf, r, h);
    finish_write(o, C.a->in[15] + C.layer * 128, 1.f, C.MIX() + ((size_t)b * SEQ + t0) * DM + hd * 128, DM, r, h);
}
DI void unit_diff(LAS unsigned char* lds, const Ctx& C, int b, int hd, int qb) {
    const int tid = otid(), lane = tid & 63, w = __builtin_amdgcn_readfirstlane(tid >> 6), r = lane & 31, h = lane >> 5;
    LAS float* wsf = (LAS float*)(lds + OFF_WS + w * 256); const Args& a = *C.a; const int L = C.layer;
    const float lam_init = 0.8f - 0.6f * expf(-0.3f * (float)L);
    const float lam = expf(wave_sum(a.in[18][L * 64 + lane] * a.in[19][L * 64 + lane])) - expf(wave_sum(a.in[20][L * 64 + lane] * a.in[21][L * 64 + lane])) + lam_init;
    const float slope2 = exp2f(-(float)(2 * hd + 1)) * LOG2E;
    const int t0 = qb * 256 + w * 32, t = t0 + r; const size_t tok = (size_t)b * SEQ + t;
    const bf16_t* vbase = C.VTD() + (size_t)((b * 4 + hd) * 128) * SEQ;
    float* stash = (float*)(C.ws + WS_STASH) + (size_t)blockIdx.x * 32768; const int nt = 4 * qb + 4;
    f32x16 o[4];
#pragma unroll 1
    for (int which = 0; which < 2; ++which) {
        bf16x8 qf[4];
#pragma unroll
        for (int ks = 0; ks < 4; ++ks) qf[ks] = *(const bf16x8*)(C.U() + tok * NU + U_DQ + hd * 128 + which * 64 + 16 * ks + 8 * h);
        const bf16_t* kbase = C.U() + (size_t)b * SEQ * NU + U_DK + hd * 128 + which * 64;
        zero_o(o); float m = NEG, l = 0.f;
        Pre P; prefetch<64>(tid, P, kbase, NU, vbase, SEQ, true);
        for (int j = 0; j < nt; ++j) {
            __syncthreads(); commit<64>(tid, P, lds, true); __syncthreads();
            if (j + 1 < nt) prefetch<64>(tid, P, kbase + (size_t)(j + 1) * 64 * NU, NU, vbase + (j + 1) * 64, SEQ, true);
            const int kv0 = 64 * j;
            if (kv0 <= t0 + 31) { f32x16 p0, p1; qk<64>(p0, p1, lds, qf, r, h);
                bias_mask(p0, p1, kv0, t, h, slope2, kv0 + 63 > t0);
                softmax_step(p0, p1, m, l, o, wsf, r, h, true); pv(o, p0, p1, lds, r, h); }
        }
        l += __shfl_xor(l, 32); scale_rows(o, (which == 0 ? 1.0f : -lam) / fmaxf(l, 1e-30f), wsf, r, h);
        if (which == 0) stash_store(stash, o, tid); else stash_add(stash, o, tid);
    }
    finish_write(o, a.in[22] + L * 128, 1.0f - lam_init, C.MIX() + ((size_t)b * SEQ + t0) * DM + 512 + hd * 128, DM, r, h);
}
DI float softplus2(float z) { return fmaxf(z, 0.f) + __builtin_amdgcn_logf(1.0f + __builtin_amdgcn_exp2f(-fabsf(z))); }
DI void unit_sb(LAS unsigned char* lds, const Ctx& C, int b, int hd, int qb) {
    const int tid = otid(), lane = tid & 63, w = __builtin_amdgcn_readfirstlane(tid >> 6), r = lane & 31, h = lane >> 5;
    const int t0 = qb * 256 + w * 32, t = t0 + r; const size_t tok = (size_t)b * SEQ + t;
    bf16x8 qf[8];
#pragma unroll
    for (int ks = 0; ks < 8; ++ks) qf[ks] = *(const bf16x8*)(C.U() + tok * NU + U_SQ + hd * 128 + 16 * ks + 8 * h);
    const bf16_t* kbase = C.U() + (size_t)b * SEQ * NU + U_SK + hd * 128; const bf16_t* vbase = C.VTS() + (size_t)((b * 4 + hd) * 128) * SEQ;
    f32x16 o[4]; zero_o(o); float cum = 0.f;
    const int nt = 4 * qb + 4;
    Pre P; prefetch<128>(tid, P, kbase + (size_t)(nt - 1) * 64 * NU, NU, vbase + (nt - 1) * 64, SEQ, true);
    LAS int* votes = (LAS int*)(lds + OFF_MISC + 16);
    for (int j = nt - 1; j >= 0; --j) {
        __syncthreads();
        if (j < nt - 1) { int alld = 1;
#pragma unroll
            for (int i = 0; i < 8; ++i) alld &= votes[i];
            if (__builtin_amdgcn_readfirstlane(alld)) break; }
        commit<128>(tid, P, lds, true); __syncthreads();
        if (j > 0) prefetch<128>(tid, P, kbase + (size_t)(j - 1) * 64 * NU, NU, vbase + (j - 1) * 64, SEQ, true);
        const int kv0 = 64 * j;
        if (kv0 < t0 + 31) { f32x16 p0, p1; qk<128>(p0, p1, lds, qf, r, h);
            const int d0 = kv0 + 4 * h - t; f32x16 s0, s1;
#pragma unroll
            for (int e = 0; e < 16; ++e) { const int dk = d0 + (e & 3) + 8 * (e >> 2); s0[e] = (dk < 0) ? softplus2(p0[e]) : 0.f; s1[e] = (dk + 32 < 0) ? softplus2(p1[e]) : 0.f; }
            float Gs[8], Go[8];
#pragma unroll
            for (int k = 0; k < 4; ++k) { Gs[k] = (s0[4 * k] + s0[4 * k + 1]) + (s0[4 * k + 2] + s0[4 * k + 3]); Gs[k + 4] = (s1[4 * k] + s1[4 * k + 1]) + (s1[4 * k + 2] + s1[4 * k + 3]); }
#pragma unroll
            for (int k = 0; k < 8; ++k) Go[k] = __shfl_xor(Gs[k], 32);
            float T = 0.f;
#pragma unroll
            for (int k = 7; k >= 0; --k) { float base = cum - T - (h == 0 ? Go[k] : 0.f);
                if (k < 4) {
                    float e3 = base;            float e2 = e3 - s0[4 * k + 3]; float e1 = e2 - s0[4 * k + 2]; float e0 = e1 - s0[4 * k + 1];
                    const int dk = d0 + 8 * k;
                    p0[4 * k + 3] = (dk + 3 < 0) ? __builtin_amdgcn_exp2f(p0[4 * k + 3] - s0[4 * k + 3] + e3) : 0.f;
                    p0[4 * k + 2] = (dk + 2 < 0) ? __builtin_amdgcn_exp2f(p0[4 * k + 2] - s0[4 * k + 2] + e2) : 0.f;
                    p0[4 * k + 1] = (dk + 1 < 0) ? __builtin_amdgcn_exp2f(p0[4 * k + 1] - s0[4 * k + 1] + e1) : 0.f;
                    p0[4 * k + 0] = (dk + 0 < 0) ? __builtin_amdgcn_exp2f(p0[4 * k + 0] - s0[4 * k + 0] + e0) : 0.f;
                } else { const int kk = k - 4;
                    float e3 = base;            float e2 = e3 - s1[4 * kk + 3]; float e1 = e2 - s1[4 * kk + 2]; float e0 = e1 - s1[4 * kk + 1];
                    const int dk = d0 + 8 * k;
                    p1[4 * kk + 3] = (dk + 3 < 0) ? __builtin_amdgcn_exp2f(p1[4 * kk + 3] - s1[4 * kk + 3] + e3) : 0.f;
                    p1[4 * kk + 2] = (dk + 2 < 0) ? __builtin_amdgcn_exp2f(p1[4 * kk + 2] - s1[4 * kk + 2] + e2) : 0.f;
                    p1[4 * kk + 1] = (dk + 1 < 0) ? __builtin_amdgcn_exp2f(p1[4 * kk + 1] - s1[4 * kk + 1] + e1) : 0.f;
                    p1[4 * kk + 0] = (dk + 0 < 0) ? __builtin_amdgcn_exp2f(p1[4 * kk + 0] - s1[4 * kk + 0] + e0) : 0.f; }
                T += Gs[k] + Go[k]; }
            cum -= T;
            pv(o, p0, p1, lds, r, h); }
        { const int dn = __all(cum < -160.0f) ? 1 : 0; if (lane == 0) votes[w] = dn; }
    }
    finish_write(o, C.a->in[32] + C.layer * 128, 1.f, C.MIX() + ((size_t)b * SEQ + t0) * DM + 1536 + hd * 128, DM, r, h);
}
DI void cmp_bias_mask(f32x16& p0, f32x16& p1, int n0, int t, int h, float slope2) {
    const int c0 = 16 * (n0 + 4 * h) + 31 - t;
#pragma unroll
    for (int e = 0; e < 16; ++e) { const int ce = c0 + 16 * ((e & 3) + 8 * (e >> 2));
        p0[e] = (ce > 0) ? NEG : fmaf(slope2, (float)ce, p0[e]); p1[e] = (ce + 512 > 0) ? NEG : fmaf(slope2, (float)(ce + 512), p1[e]); }
}
DI void unit_nsa(LAS unsigned char* lds, const Ctx& C, int b, int qb) {
    const int tid = otid(), lane = tid & 63, w = __builtin_amdgcn_readfirstlane(tid >> 6), r = lane & 31, h = lane >> 5, hd = w >> 1, qh = w & 1;
    LAS float* wsf = (LAS float*)(lds + OFF_WS + w * 256); LAS float* imp = (LAS float*)(lds + OFF_IMP); LAS unsigned long long* sel = (LAS unsigned long long*)(lds + OFF_SEL);
    const int t0 = qb * 64 + qh * 32, t = t0 + r, ql = qh * 32 + r; const size_t tok = (size_t)b * SEQ + t;
    bf16x8 qf[8];
#pragma unroll
    for (int ks = 0; ks < 8; ++ks) qf[ks] = *(const bf16x8*)(C.U() + tok * NU + U_NQ + hd * 128 + 16 * ks + 8 * h);
    const bf16_t* gp = C.U() + tok * NU + U_G + hd * 3;
    const float g0 = 1.0f / (1.0f + __expf(-bf2f(gp[0]))), g1 = 1.0f / (1.0f + __expf(-bf2f(gp[1]))), g2 = 1.0f / (1.0f + __expf(-bf2f(gp[2])));
    const float slope2 = exp2f(-(float)(2 * hd + 2)) * LOG2E;
    for (int i = tid; i < 4096; i += 512) imp[i] = 0.f;
    float* stash = (float*)(C.ws + WS_STASH) + (size_t)blockIdx.x * 32768; f32x16 o[4]; Pre P;
    const bf16_t* kcb = C.KC() + (size_t)b * 256 * 128; const bf16_t* vcb = C.VTVC() + (size_t)b * 128 * 256; const int ntc = (4 * qb + 2) / 64 + 1;
    float m = NEG, l = 0.f;
    prefetch<128>(tid, P, kcb, 128, vcb, 256, false);
    for (int j = 0; j < ntc; ++j) {
        __syncthreads(); commit<128>(tid, P, lds, false); __syncthreads();
        if (j + 1 < ntc) prefetch<128>(tid, P, kcb + (size_t)(j + 1) * 64 * 128, 128, vcb, 256, false);
        f32x16 p0, p1; qk<128>(p0, p1, lds, qf, r, h); cmp_bias_mask(p0, p1, 64 * j, t, h, slope2); softmax_step(p0, p1, m, l, o, wsf, r, h, false);
    }
    l += __shfl_xor(l, 32);
    { const float mu = (m < 0.5f * NEG) ? 0.f : m; const float il = 1.0f / fmaxf(l, 1e-30f);
      zero_o(o); prefetch<128>(tid, P, kcb, 128, vcb, 256, true);
      for (int j = 0; j < ntc; ++j) {
          __syncthreads(); commit<128>(tid, P, lds, true); __syncthreads();
          if (j + 1 < ntc) prefetch<128>(tid, P, kcb + (size_t)(j + 1) * 64 * 128, 128, vcb + (j + 1) * 64, 256, true);
          f32x16 p0, p1; qk<128>(p0, p1, lds, qf, r, h); cmp_bias_mask(p0, p1, 64 * j, t, h, slope2);
#pragma unroll
          for (int e = 0; e < 16; ++e) { p0[e] = __builtin_amdgcn_exp2f(p0[e] - mu) * il; p1[e] = __builtin_amdgcn_exp2f(p1[e] - mu) * il; }
#pragma unroll
          for (int g = 0; g < 4; ++g) { const int jb = 16 * j + 2 * g + h; LAS float* ip = imp + ql * 64 + jb;
              __hip_atomic_fetch_add(ip, (p0[4 * g] + p0[4 * g + 1]) + (p0[4 * g + 2] + p0[4 * g + 3]), __ATOMIC_RELAXED, __HIP_MEMORY_SCOPE_WORKGROUP);
              __hip_atomic_fetch_add(ip + 1, p0[4 * g + 3], __ATOMIC_RELAXED, __HIP_MEMORY_SCOPE_WORKGROUP);
              __hip_atomic_fetch_add(ip + 8, (p1[4 * g] + p1[4 * g + 1]) + (p1[4 * g + 2] + p1[4 * g + 3]), __ATOMIC_RELAXED, __HIP_MEMORY_SCOPE_WORKGROUP);
              if (jb + 9 < 64) __hip_atomic_fetch_add(ip + 9, p1[4 * g + 3], __ATOMIC_RELAXED, __HIP_MEMORY_SCOPE_WORKGROUP); }
          pv(o, p0, p1, lds, r, h);
      }
      scale_rows(o, g0, wsf, r, h); stash_store(stash, o, tid); }
    __syncthreads();
    for (int qi = 0; qi < 8; ++qi) { const int q = 8 * w + qi; const float v = imp[q * 64 + lane];
        const bool valid = lane <= qb, forced = (lane == 0) || (lane == qb) || (lane == qb - 1); const float key = forced ? 3.0e38f : v; int rank = 0;
        for (int jj = 0; jj <= qb; ++jj) { const float kj = __shfl(key, jj); rank += ((kj > key) || (kj == key && jj < lane)) ? 1 : 0; }
        const unsigned long long mk = __ballot(valid && rank < 16);
        if (lane == 0) sel[q] = mk; }
    __syncthreads();
    const unsigned long long selq = sel[ql];
    unsigned long long un;
    { unsigned long long u = sel[lane]; unsigned lo = (unsigned)u, hi = (unsigned)(u >> 32);
#pragma unroll
      for (int of = 1; of < 64; of <<= 1) { lo |= __shfl_xor(lo, of); hi |= __shfl_xor(hi, of); }
      un = ((unsigned long long)(unsigned)__builtin_amdgcn_readfirstlane((int)hi) << 32) | (unsigned long long)(unsigned)__builtin_amdgcn_readfirstlane((int)lo); }
    { const bf16_t* kb = C.U() + (size_t)b * SEQ * NU + U_KS; const bf16_t* vb = C.VTVS() + (size_t)b * 128 * SEQ;
      m = NEG; l = 0.f; zero_o(o); unsigned long long rem = un;
      if (rem) { const int j0 = __builtin_ctzll(rem); prefetch<128>(tid, P, kb + (size_t)j0 * 64 * NU, NU, vb + j0 * 64, SEQ, true); }
      while (rem) { const int j = __builtin_ctzll(rem); rem &= rem - 1;
          __syncthreads(); commit<128>(tid, P, lds, true); __syncthreads();
          if (rem) { const int jn = __builtin_ctzll(rem); prefetch<128>(tid, P, kb + (size_t)jn * 64 * NU, NU, vb + jn * 64, SEQ, true); }
          const bool mine = (selq >> j) & 1ull;
          if (__any(mine)) { f32x16 p0, p1; qk<128>(p0, p1, lds, qf, r, h); bias_mask(p0, p1, 64 * j, t, h, slope2, true);
              if (!mine) {
#pragma unroll
                  for (int e = 0; e < 16; ++e) { p0[e] = NEG; p1[e] = NEG; } }
              softmax_step(p0, p1, m, l, o, wsf, r, h, true); pv(o, p0, p1, lds, r, h); }
      }
      l += __shfl_xor(l, 32); scale_rows(o, g1 / fmaxf(l, 1e-30f), wsf, r, h); stash_add(stash, o, tid); stash_store(stash, o, tid); }
    { const bf16_t* kb = C.U() + (size_t)b * SEQ * NU + U_KW; const bf16_t* vb = C.VTVW() + (size_t)b * 128 * SEQ;
      m = NEG; l = 0.f; zero_o(o); const int jlo = qb > 8 ? qb - 8 : 0;
      prefetch<128>(tid, P, kb + (size_t)jlo * 64 * NU, NU, vb + jlo * 64, SEQ, true);
      for (int j = jlo; j <= qb; ++j) {
          __syncthreads(); commit<128>(tid, P, lds, true); __syncthreads();
          if (j < qb) prefetch<128>(tid, P, kb + (size_t)(j + 1) * 64 * NU, NU, vb + (j + 1) * 64, SEQ, true);
          f32x16 p0, p1; qk<128>(p0, p1, lds, qf, r, h);
          const int d0 = 64 * j + 4 * h - t;
#pragma unroll
          for (int e = 0; e < 16; ++e) { const int dk = d0 + (e & 3) + 8 * (e >> 2);
              p0[e] = (dk > 0 || dk <= -512) ? NEG : fmaf(slope2, (float)dk, p0[e]); p1[e] = (dk + 32 > 0 || dk + 32 <= -512) ? NEG : fmaf(slope2, (float)(dk + 32), p1[e]); }
          softmax_step(p0, p1, m, l, o, wsf, r, h, true); pv(o, p0, p1, lds, r, h);
      }
      l += __shfl_xor(l, 32); scale_rows(o, g2 / fmaxf(l, 1e-30f), wsf, r, h); stash_add(stash, o, tid); }
    finish_write(o, C.a->in[31] + C.layer * 128, 1.f, C.MIX() + ((size_t)b * SEQ + t0) * DM + 1024 + hd * 128, DM, r, h);
}
DI void attn_phase(LAS unsigned char* lds, const Ctx& C, unsigned* ctr) {
    LAS int* misc = (LAS int*)(lds + OFF_MISC);
    for (;;) {
        __syncthreads();
        if (otid() == 0) misc[0] = (int)__hip_atomic_fetch_add(ctr, 1u, __ATOMIC_RELAXED, __HIP_MEMORY_SCOPE_AGENT);
        __syncthreads();
        const int p = __builtin_amdgcn_readfirstlane(misc[0]);
        if (p >= 1024) break;
        int type, bh, qb;
        if (p < 384) { const int g = p / 48, q = p - 48 * g; qb = 15 - g; type = q >> 4; bh = q & 15; }
        else if (p < 640) { const int u = p - 384; type = 3; qb = 63 - (u >> 2); bh = u & 3; }
        else { const int pp = p - 640, g = pp / 48, q = pp - 48 * g; qb = 7 - g; type = q >> 4; bh = q & 15; }
#ifndef NO_DIFF
        if (type == 0) unit_diff(lds, C, bh >> 2, bh & 3, qb);
#endif
#ifndef NO_SB
        if (type == 1) unit_sb(lds, C, bh >> 2, bh & 3, qb);
#endif
#ifndef NO_MLA
        if (type == 2) unit_mla(lds, C, bh >> 2, bh & 3, qb);
#endif
#ifndef NO_NSA
        if (type == 3) unit_nsa(lds, C, bh, qb);
#endif
    }
}
}

#ifndef PROBE_DOUBLE
#define PROBE_DOUBLE 0
#endif
#ifndef PHMASK
#define PHMASK 0xffffffffu
#endif
constexpr int LDS_BYTES = 147456;
static_assert(att::LDS_END <= 131072, "attention LDS map");
#define RLX_AGENT __ATOMIC_RELAXED, __HIP_MEMORY_SCOPE_AGENT
#define XB_TMO      128
#define XB_XCNT(j)  (256  + 64 * (j))
#define XB_XSUB(j)  (1280 + 64 * (j))
#define XB_XGEN(j)  (2304 + 64 * (j))
#define XB_TOP      3328
#define XB_TOPGEN   3392
#define XCD_BAR_WORDS 3456
#define XB_SPIN_CAP (1u << 18)

__device__ __forceinline__ unsigned xb_ld(unsigned* p)              { return __hip_atomic_load(p, __ATOMIC_RELAXED, __HIP_MEMORY_SCOPE_AGENT); }
__device__ __forceinline__ unsigned xb_add(unsigned* p, unsigned v) { return __hip_atomic_fetch_add(p, v, __ATOMIC_RELAXED, __HIP_MEMORY_SCOPE_AGENT); }
__device__ __forceinline__ unsigned xb_xcc_id() { return (unsigned)__builtin_amdgcn_s_getreg((3 << 11) | 20) & 0xFu; }
#define XB_SPIN(cond, bar) do { unsigned _sp = 0; while (cond) { __builtin_amdgcn_s_sleep(1); \
    if ((++_sp & 255u) == 0u) { if (xb_ld(&(bar)[XB_TMO])) break; if (_sp > XB_SPIN_CAP) { atomicAdd(&(bar)[XB_TMO], 1u); break; } } } } while (0)

struct XcdBarrier {
    unsigned* bar; unsigned x;
    volatile LAS unsigned* st;
};

__device__ __forceinline__ XcdBarrier xcd_barrier_post(unsigned* bar, volatile LAS unsigned* st) {
    XcdBarrier b; b.bar = bar; b.x = xb_xcc_id(); b.st = st;
    if (threadIdx.x == 0) (void)xb_add(&bar[XB_XCNT(b.x)], 1u);
    return b;
}
__device__ __forceinline__ void xcd_barrier_complete(unsigned* bar, unsigned x, unsigned& nloc, unsigned& nx) {
    const unsigned G = gridDim.x * gridDim.y * gridDim.z;
    unsigned sum, cnt, mine, sp = 0u;
    for (;;) {
        sum = 0u; cnt = 0u; mine = 0u;
#pragma unroll
        for (unsigned j = 0; j < 16; ++j) { const unsigned c = xb_ld(&bar[XB_XCNT(j)]); sum += c; cnt += (c > 0u) ? 1u : 0u; mine = (j == x) ? c : mine; }
        if (sum == G) break;
        __builtin_amdgcn_s_sleep(1);
        if ((++sp & 255u) == 0u) { if (xb_ld(&bar[XB_TMO])) break; if (sp > XB_SPIN_CAP) { atomicAdd(&bar[XB_TMO], 1u); break; } }
    }
    nloc = mine > 0u ? mine : 1u; nx = cnt > 0u ? cnt : 1u;
}

__device__ __forceinline__ void xcd_barrier(const XcdBarrier& b) {
    asm volatile("s_waitcnt vmcnt(0)" ::: "memory");
    __syncthreads();
    if (threadIdx.x == 0) {
        unsigned* bar = b.bar;
        __builtin_amdgcn_s_waitcnt(0);
        unsigned nloc = b.st[0], nx = b.st[1];
        if (nloc == 0u) { xcd_barrier_complete(bar, b.x, nloc, nx); b.st[0] = nloc; b.st[1] = nx; }
        const unsigned old = xb_add(&bar[XB_XSUB(b.x)], 1u);
        const unsigned gen = old / nloc;
        if (old + 1u == (gen + 1u) * nloc) {
            __builtin_amdgcn_fence(__ATOMIC_RELEASE, "agent");
            asm volatile("s_waitcnt vmcnt(0)" ::: "memory");
            const unsigned og = xb_add(&bar[XB_TOP], 1u);
            const unsigned tg = og / nx;
            if (og + 1u == (tg + 1u) * nx) xb_add(&bar[XB_TOPGEN], 1u);
            else XB_SPIN(xb_ld(&bar[XB_TOPGEN]) == tg, bar);
            __builtin_amdgcn_fence(__ATOMIC_ACQUIRE, "agent");
            xb_add(&bar[XB_XGEN(b.x)], 1u);
            asm volatile("s_waitcnt vmcnt(0)" ::: "memory");
        } else {
            XB_SPIN(xb_ld(&bar[XB_XGEN(b.x)]) == gen, bar);
            __builtin_amdgcn_fence(__ATOMIC_ACQUIRE, "agent");
            asm volatile("s_waitcnt vmcnt(0)" ::: "memory");
        }
    }
    __syncthreads();
}

struct GemmDesc { const bf16_t* A; int lda; const void* Bt; int ldb; int M, N, K; pg8::EpiAny E; int crot; };
DI GemmDesc get_gemm(const Ctx& C, const Args& a, int s, int gi) {
    unsigned char* wl = C.wl(); float* hres = a.out; GemmDesc d; d.crot = 0;
    d.E.mode = 0; d.E.O = nullptr; d.E.ldc = 0; d.E.ncols = 0; d.E.base = nullptr; d.E.out = nullptr; d.E.alpha = 0.f;
    if (s == 0 || s == 10) { d.A = C.XN(); d.lda = DM; d.Bt = wl + (s == 0 ? W_GU1 : W_GU2); d.M = NTOK; d.N = 2 * DFF; d.K = DM; d.E.mode = 1; d.E.O = C.HID(); d.E.ldc = DFF; }
    else if (s == 1 || s == 11) { d.A = C.HID(); d.lda = DFF; d.Bt = wl + (s == 1 ? W_D1 : W_D2); d.M = NTOK; d.N = DM; d.K = DFF; d.E.mode = 2;
        d.E.base = (s == 1 && C.layer == 0) ? a.in[0] : hres; d.E.out = hres; d.E.ldc = DM; d.E.alpha = 0.5f; }
    else if (s == 3) { d.A = C.XN(); d.lda = DM; d.Bt = wl + W_IN; d.M = NTOK; d.N = NU; d.K = DM; d.E.O = C.U(); d.E.ldc = NU; d.E.ncols = NU; }
    else if (s == 8) { d.A = C.MIX(); d.lda = DM; d.Bt = wl + W_OUT; d.M = NTOK; d.N = DM; d.K = DM; d.E.mode = 2; d.E.base = hres; d.E.out = hres; d.E.ldc = DM; d.E.alpha = 1.0f; }
    else if (gi == 0) { d.A = C.U() + U_CQ; d.lda = NU; d.Bt = wl + W_UQ; d.M = NTOK; d.N = 768; d.K = 512; d.E.O = C.QM(); d.E.ldc = 768; d.E.ncols = 768; }
    else if (gi == 1) { d.A = C.U() + U_CKV; d.lda = NU; d.Bt = wl + W_UKV; d.M = NTOK; d.N = 1024; d.K = 256; d.E.O = C.KVR(); d.E.ldc = 1024; d.E.ncols = 1024; }
    else { const int which = (gi - 2) >> 3, ks = (gi - 2) & 7;
        d.A = (which ? C.AV() : C.AK()) + ks * 512; d.lda = 4096; d.Bt = (const bf16_t*)(wl + (which ? W_CV : W_CK)) + ks * 512; d.ldb = 4096; d.M = 1024; d.N = 256; d.K = 512;
        d.E.mode = 3; d.E.out = C.PART() + (size_t)(gi - 2) * 1024 * 128; d.E.ldc = 128; d.E.ncols = 128; d.crot = 16 * (gi - 2); }
    if (s != 5 || gi < 2) d.ldb = d.K;
    return d;
}
__global__ void __launch_bounds__(512, 2) mega_fwd(Args a) {
    extern __shared__ __attribute__((aligned(16))) unsigned char lds_raw[];
    LAS unsigned char* lds = (LAS unsigned char*)lds_raw;
    cg::grid_group grid = cg::this_grid();
    const int NSTEP = 13 * NLAYER;
    volatile LAS unsigned* MISC = (volatile LAS unsigned*)(lds + 131072 + 320);
    if (threadIdx.x < 32) MISC[threadIdx.x] = 0u;
    __syncthreads();
#pragma unroll 1
    for (int step = 0; step < NSTEP; ++step) {
        if (step >= a.ph_lo && step < a.ph_hi) {
            const int tid = otid(), lane = tid & 63, wave = __builtin_amdgcn_readfirstlane(tid >> 6);
            const int G = gridDim.x, c = blockIdx.x, gw = c * 8 + wave, NGW = G * 8;
            if (step == 0) {
                { const XcdBarrier b0 = xcd_barrier_post((unsigned*)(a.ws + WS_CTL) + 1024, MISC + 8); if (threadIdx.x == 0) MISC[10] = b0.x; }
#ifndef NO_P0
                for (int rep = 0; rep < (PROBE_DOUBLE == 3 ? 2 : 1); ++rep) p0_weights(a, lds, gw, NGW, wave, lane);
                norm_rows(a.in[0], (bf16_t*)(a.ws + WS_XN), gw, NGW, lane);
#endif
            }
            else {
                const int L = (step - 1) / 13, s = (step - 1) - 13 * L; const Ctx C = make_ctx(a, L);
                const int ng = (s == 0 || s == 1 || s == 3 || s == 8 || s == 10 || s == 11) ? 1 : (s == 5 ? 18 : 0);
                if (ng) {
#pragma unroll 1
                    for (int gi0 = 0; gi0 < ng * ((PROBE_DOUBLE == 2 && (s == 0 || s == 10)) ? 2 : 1); ++gi0) { const int gi = gi0 % ng; const GemmDesc d = get_gemm(C, a, s, gi);
                        pg8::Gemm g{d.A, (const bf16_t*)d.Bt, d.M, d.N, d.K, d.lda, d.ldb}; pg8::StaticOrder S; S.init(d.M, d.N, G, (c + G - (d.crot % G)) % G);
                        pg8::gemm_phase<pg8::EpiAny, pg8::StaticOrder, true, true>(lds, g, S, d.E); }
                }
#ifndef NO_NORM
                else if (s == 2 || s == 9 || s == 12) norm_rows(a.out, C.XN(), gw, NGW, lane);
#endif
#ifndef NO_FIX
                else if (s == 4) fix1(C, gw, NGW, lane);
                else if (s == 6) fix2(C, gw, NGW, lane);
#endif
                else if (s == 7) { att::attn_phase(lds, C, (unsigned*)(a.ws + WS_CTL) + 64 + 64 * L);
#if PROBE_DOUBLE == 1
                    att::attn_phase(lds, C, (unsigned*)(a.ws + WS_CTL) + 256 + 64 * L);
#endif
                }
            }
        }
        if (step >= a.ph_lo && step + 1 < a.ph_hi && step + 1 < NSTEP) { if (step == 0) grid.sync(); else { XcdBarrier bar; bar.bar = (unsigned*)(a.ws + WS_CTL) + 1024; bar.st = MISC + 8; bar.x = MISC[10]; xcd_barrier(bar); } }
    }
}

extern "C" void kernel_launch(void* const* d_in, const int* in_sizes, int n_in, void* d_out, int out_size, void* d_ws, size_t ws_size, hipStream_t stream) {
    static int grid = 0;
    if (grid == 0) {
        if (n_in != 38 || out_size != NTOK * DM || ws_size < WS_END + 8 * MiB) { fprintf(stderr, "kernel_launch: unexpected shapes (n_in %d, out %d, ws %zu, need %zu)\n", n_in, out_size, ws_size, (size_t)WS_END); grid = -1; return; }
        int dev = 0, cus = 0, per_cu = 0;
        if (hipGetDevice(&dev) != hipSuccess || hipDeviceGetAttribute(&cus, hipDeviceAttributeMultiprocessorCount, dev) != hipSuccess) { grid = -1; return; }
        if (hipFuncSetAttribute((const void*)mega_fwd, hipFuncAttributeMaxDynamicSharedMemorySize, LDS_BYTES) != hipSuccess) { fprintf(stderr, "kernel_launch: hipFuncSetAttribute failed\n"); grid = -1; return; }
        if (hipOccupancyMaxActiveBlocksPerMultiprocessor(&per_cu, (const void*)mega_fwd, 512, LDS_BYTES) != hipSuccess || per_cu < 1) { fprintf(stderr, "kernel_launch: occupancy query says %d\n", per_cu); (void)hipGetLastError(); }
        grid = cus;
    }
    if (grid < 0) return;
    (void)hipMemsetAsync((char*)d_ws + WS_CTL, 0, 32768, stream);
    Args a{};
    for (int i = 0; i < 38; ++i) a.in[i] = (const float*)d_in[i];
    a.out = (float*)d_out; a.ws = (unsigned char*)d_ws;
    for (int i = 0; i < 32; ++i) a.inv_freq[i] = (float)pow(10000.0, -(double)(2 * i) / 64.0);
    a.ph_lo = 0; a.ph_hi = 1 << 20;
    void* args[] = {&a};
    hipError_t e = hipLaunchCooperativeKernel((const void*)mega_fwd, dim3(grid), dim3(512), args, LDS_BYTES, stream);
    if (e != hipSuccess) fprintf(stderr, "kernel_launch: cooperative launch failed: %s (grid %d)\n", hipGetErrorString(e), grid);
}
```

```cpp
#include <hip/hip_runtime.h>
#include <hip/hip_cooperative_groups.h>
#include <cstdio>
#include <cstdint>
#include <cmath>
namespace cg = cooperative_groups;
namespace pg8 {
#define PG8_LAS __attribute__((address_space(3)))
typedef unsigned short bf16_t;
typedef short bf16x8 __attribute__((ext_vector_type(8)));
typedef float f32x4 __attribute__((ext_vector_type(4)));
typedef unsigned u32x4 __attribute__((ext_vector_type(4)));
constexpr int BM = 256, BK = 64, HALF = 128, HTB = HALF * BK * 2  , STAGE_BYTES = 8 * HTB, NXCD = 8, WGM = 8;

__host__ __device__ __forceinline__ int lds_byte(int r, int c) { const int st = (r >> 4) * 2 + (c >> 5), rr = r & 15, cc = c & 31, ob = rr * 64 + cc * 2; return st * 1024 + (ob ^ (((ob >> 9) & 1) << 5)); }
__host__ __device__ __forceinline__ void stage_rc(int b, int& R, int& C) { const int st = b / 1024, sb = b % 1024, swz = sb ^ (((sb >> 9) & 1) << 5); R = (st >> 1) * 16 + swz / 64; C = (st & 1) * 32 + (swz % 64) / 2; }
__host__ __device__ __forceinline__ int perm32(int rho) { const int n = rho >> 4, i = rho & 15; return 8 * (i >> 2) + 4 * n + (i & 3); }

struct Unit { int pm, pn; };
struct Gemm { const bf16_t* A; const bf16_t* Bt; int M, N, K, lda; };

struct StaticOrder {
    int nM, nN, nwg, G, c;
    __host__ __device__ void init(int M, int N, int G_, int c_) { nM = M / BM; nN = N / BM; nwg = nM * nN; G = G_; c = c_; }
    __host__ __device__ bool next(int i, Unit& u) const {
        const long L = (long)i * G + c; if (L >= nwg) return false;
        int wgid = (int)L; { const int q = nwg / NXCD, r = nwg % NXCD, xcd = wgid % NXCD, off = wgid / NXCD; wgid = (xcd < r ? xcd * (q + 1) : r * (q + 1) + (xcd - r) * q) + off; }
        const int nig = WGM * nN, gid = wgid / nig, fm = gid * WGM, gsz = (nM - fm) < WGM ? (nM - fm) : WGM;
        u.pm = fm + ((wgid % nig) % gsz); u.pn = (wgid % nig) / gsz; return true;
    }
    __device__ __forceinline__ void a_ready(const Unit&) const {}
    __device__ __forceinline__ void done(const Unit&) const {}
};

__device__ __forceinline__ unsigned cvt_pk_bf16(float lo, float hi) { unsigned r; asm volatile("v_cvt_pk_bf16_f32 %0, %1, %2" : "=v"(r) : "v"(lo), "v"(hi)); return r; }
typedef float f32x2 __attribute__((ext_vector_type(2)));
struct EpiStoreBf16 {
    static constexpr bool PERM = true, AFTER_DRAIN = false;
    bf16_t* O; int ldc; int ncols;
    __device__ __forceinline__ void operator()(const f32x4 (&acc)[2][2][4][2], const Unit& u, int wr, int wc, int fr, int fq) const {
        const int row0 = u.pm * BM + wr * 64 + fr; const int col0 = u.pn * BM + wc * 32 + 8 * fq;
#pragma unroll
        for (int ai = 0; ai < 2; ++ai)
#pragma unroll
            for (int m = 0; m < 4; ++m) { bf16_t* rowp = O + (size_t)(row0 + ai * HALF + m * 16) * ldc;
#pragma unroll
                for (int bj = 0; bj < 2; ++bj) { const int c = col0 + bj * HALF;
                    if (c < ncols) { const f32x4 v0 = acc[ai][bj][m][0], v1 = acc[ai][bj][m][1]; u32x4 w;
                        w.x = cvt_pk_bf16(v0[0], v0[1]); w.y = cvt_pk_bf16(v0[2], v0[3]); w.z = cvt_pk_bf16(v1[0], v1[1]); w.w = cvt_pk_bf16(v1[2], v1[3]);
                        *(u32x4*)(rowp + c) = w; } } }
    }
};
struct EpiSwiGLU {
    static constexpr bool PERM = true, AFTER_DRAIN = false;
    bf16_t* H; int ldc;
    __device__ __forceinline__ void operator()(const f32x4 (&acc)[2][2][4][2], const Unit& u, int wr, int wc, int fr, int fq) const {
        const int row0 = u.pm * BM + wr * 64 + fr; const int col0 = u.pn * HALF + wc * 32 + 8 * fq;
#pragma unroll
        for (int ai = 0; ai < 2; ++ai)
#pragma unroll
            for (int m = 0; m < 4; ++m) { bf16_t* rowp = H + (size_t)(row0 + ai * HALF + m * 16) * ldc + col0;
                float r[8];
#pragma unroll
                for (int n = 0; n < 2; ++n)
#pragma unroll
                    for (int e = 0; e < 4; ++e) { const float g = acc[ai][0][m][n][e], up = acc[ai][1][m][n][e];
                        r[n * 4 + e] = g * up * __builtin_amdgcn_rcpf(1.0f + __expf(-g)); }
                u32x4 w; w.x = cvt_pk_bf16(r[0], r[1]); w.y = cvt_pk_bf16(r[2], r[3]); w.z = cvt_pk_bf16(r[4], r[5]); w.w = cvt_pk_bf16(r[6], r[7]);
                *(u32x4*)rowp = w; }
    }
};
struct EpiResid {
    static constexpr bool PERM = false, AFTER_DRAIN = false;
    const float* base; float* out; int ldc; float alpha;
    __device__ __forceinline__ void operator()(const f32x4 (&acc)[2][2][4][2], const Unit& u, int wr, int wc, int fr, int fq) const {
        const int row0 = u.pm * BM + wr * 64 + fr; const int col0 = u.pn * BM + wc * 32 + 4 * fq;
#pragma unroll
        for (int ai = 0; ai < 2; ++ai) {
            f32x4 b[4][2][2];
#pragma unroll
            for (int m = 0; m < 4; ++m) { const size_t off = (size_t)(row0 + ai * HALF + m * 16) * ldc + col0;
#pragma unroll
                for (int bj = 0; bj < 2; ++bj)
#pragma unroll
                    for (int n = 0; n < 2; ++n) b[m][bj][n] = *(const f32x4*)(base + off + bj * HALF + n * 16); }
#pragma unroll
            for (int m = 0; m < 4; ++m) { const size_t off = (size_t)(row0 + ai * HALF + m * 16) * ldc + col0;
#pragma unroll
                for (int bj = 0; bj < 2; ++bj)
#pragma unroll
                    for (int n = 0; n < 2; ++n) *(f32x4*)(out + off + bj * HALF + n * 16) = b[m][bj][n] + acc[ai][bj][m][n] * alpha; }
            asm volatile("" ::: "memory");
        }
    }
};
struct EpiAny {
    static constexpr bool AFTER_DRAIN = false;
    int mode; bf16_t* O; int ldc; int ncols; const float* base; float* out; float alpha;
    __device__ __forceinline__ bool perm() const { return mode != 2; }
    __device__ __forceinline__ void operator()(const f32x4 (&acc)[2][2][4][2], const Unit& u, int wr, int wc, int fr, int fq) const {
#ifndef NO_E0
        if (mode == 0) { EpiStoreBf16 e{O, ldc, ncols}; e(acc, u, wr, wc, fr, fq); }
#endif
#ifndef NO_E1
        if (mode == 1) { EpiSwiGLU e{O, ldc}; e(acc, u, wr, wc, fr, fq); }
#endif
#ifndef NO_E2
        if (mode == 2) { EpiResid e{base, out, ldc, alpha}; e(acc, u, wr, wc, fr, fq); }
#endif
    }
};
template <class Epi, class Sched, bool ALIGN_EPI = false, bool SP2 = false>
__device__ __forceinline__ void gemm_phase(PG8_LAS unsigned char* lds, const Gemm g, const Sched& S, const Epi& E) {
    int tid = threadIdx.x; asm volatile("" : "+v"(tid)); const int wid = __builtin_amdgcn_readfirstlane(tid >> 6), lane = tid & 63, wr = wid >> 2, wc = wid & 3, fr = lane & 15, fq = lane >> 4;
    const int K = g.K, nt = K / BK;
    unsigned voffA[2], voffB[2];
#pragma unroll
    for (int i = 0; i < 2; ++i) { int R, C; stage_rc(tid * 16 + i * 8192, R, C); const int Rb = E.perm() ? ((R & ~31) + perm32(R & 31)) : R;
        voffA[i] = (unsigned)(R * g.lda + C) * 2u; voffB[i] = (unsigned)(Rb * K + C) * 2u; }
    const size_t kstep = (size_t)(BK * 2);
    const size_t hstep = (size_t)HALF * K * 2;
    const size_t tstep = 2 * hstep; const size_t hstepA = (size_t)HALF * g.lda * 2, tstepA = 2 * hstepA;
    const unsigned ldsw = (unsigned)wid * 1024u;
    const int aoff = lds_byte(wr * 64 + fr, fq * 8), boff = lds_byte(wc * 32 + fr, fq * 8);
#define PG8_SA(b, h) (((b) * 2 + (h)) * HTB)
#define PG8_SB(b, h) ((4 + (b) * 2 + (h)) * HTB)
#define PG8_STAGE(bufoff, gbase, voff) do { _Pragma("unroll") for (int _i = 0; _i < 2; ++_i) \
        __builtin_amdgcn_global_load_lds((const unsigned*)((const char*)(gbase) + (voff)[_i]), (PG8_LAS unsigned*)(lds + (bufoff) + ldsw + _i * 8192), 16, 0, 0); } while (0)
#define PG8_LDA(dst, b, h) do { _Pragma("unroll") for (int m = 0; m < 4; ++m) _Pragma("unroll") for (int k = 0; k < 2; ++k) dst[m][k] = *(const PG8_LAS bf16x8*)(lds + PG8_SA(b, h) + aoff + m * 2048 + k * 1024); } while (0)
#define PG8_LDB(dst, b, h) do { _Pragma("unroll") for (int n = 0; n < 2; ++n) _Pragma("unroll") for (int k = 0; k < 2; ++k) dst[n][k] = *(const PG8_LAS bf16x8*)(lds + PG8_SB(b, h) + boff + n * 2048 + k * 1024); } while (0)
#define PG8_MMA(ai, bj, At, Bt) do { __builtin_amdgcn_s_setprio(1); _Pragma("unroll") for (int m = 0; m < 4; ++m) _Pragma("unroll") for (int n = 0; n < 2; ++n) _Pragma("unroll") for (int k = 0; k < 2; ++k) \
        acc[ai][bj][m][n] = __builtin_amdgcn_mfma_f32_16x16x32_bf16(Bt[n][k], At[m][k], acc[ai][bj][m][n], 0, 0, 0); __builtin_amdgcn_s_setprio(0); } while (0)
#define PG8_WAIT_V(n) asm volatile("s_waitcnt vmcnt(" #n ")" ::: "memory")
#define PG8_WAIT_L(n) asm volatile("s_waitcnt lgkmcnt(" #n ")" ::: "memory")
#define PG8_BAR __builtin_amdgcn_s_barrier()
#define PG8_SCHED __builtin_amdgcn_sched_barrier(0)
    Unit cur, nxt; int ui = 0;
    if (!S.next(0, cur)) return;
    f32x4 acc[2][2][4][2];
#pragma unroll
    for (int a = 0; a < 2; ++a)
#pragma unroll
        for (int b = 0; b < 2; ++b)
#pragma unroll
            for (int m = 0; m < 4; ++m)
#pragma unroll
                for (int n = 0; n < 2; ++n) acc[a][b][m][n] = (f32x4){0.f, 0.f, 0.f, 0.f};
    bf16x8 At[4][2], B0[2][2], B1[2][2];
    const char* cA = (const char*)g.A + (size_t)cur.pm * tstepA; const char* cB = (const char*)g.Bt + (size_t)cur.pn * tstep;
    S.a_ready(cur);
    if constexpr (SP2) {
        PG8_STAGE(PG8_SB(0, 0), cB, voffB); PG8_STAGE(PG8_SB(0, 1), cB + hstep, voffB); PG8_STAGE(PG8_SA(0, 0), cA, voffA); PG8_STAGE(PG8_SA(0, 1), cA + hstepA, voffA);
        if (wr == 1) PG8_BAR;
        PG8_WAIT_V(2); PG8_BAR;
        PG8_STAGE(PG8_SB(1, 0), cB + kstep, voffB); PG8_STAGE(PG8_SA(1, 0), cA + kstep, voffA); PG8_STAGE(PG8_SB(1, 1), cB + hstep + kstep, voffB);
        PG8_WAIT_V(6); PG8_BAR;
    } else {
        PG8_STAGE(PG8_SB(0, 0), cB, voffB); PG8_STAGE(PG8_SA(0, 0), cA, voffA); PG8_STAGE(PG8_SB(0, 1), cB + hstep, voffB); PG8_STAGE(PG8_SA(0, 1), cA + hstepA, voffA);
        if (wr == 1) PG8_BAR;
        PG8_WAIT_V(4); PG8_BAR;
        PG8_STAGE(PG8_SB(1, 0), cB + kstep, voffB); PG8_STAGE(PG8_SA(1, 0), cA + kstep, voffA); PG8_STAGE(PG8_SB(1, 1), cB + hstep + kstep, voffB);
        PG8_WAIT_V(6); PG8_BAR;
    }
    for (;;) {
        const bool has_next = S.next(ui + 1, nxt);
        const char* nA = has_next ? (const char*)g.A + (size_t)nxt.pm * tstepA : cA; const char* nB = has_next ? (const char*)g.Bt + (size_t)nxt.pn * tstep : cB;
        for (int t = 0; t < nt; t += 2) {
            const bool last = (t == nt - 2);
            const char* a1 = cA + (size_t)(t + 1) * kstep;
            const char* a2 = last ? nA : cA + (size_t)(t + 2) * kstep; const char* b2 = last ? nB : cB + (size_t)(t + 2) * kstep;
            const char* a3 = a2 + kstep; const char* b3 = b2 + kstep;
            if (last && has_next) S.a_ready(nxt);
            if constexpr (SP2) {
            PG8_LDB(B0, 0, 0); PG8_LDB(B1, 0, 1); PG8_SCHED; PG8_LDA(At, 0, 0); PG8_STAGE(PG8_SA(1, 1), a1 + hstepA, voffA);
            PG8_WAIT_V(8); PG8_WAIT_L(0); PG8_BAR; PG8_MMA(0, 0, At, B0); PG8_MMA(0, 1, At, B1); PG8_BAR; PG8_SCHED;
            PG8_LDA(At, 0, 1); PG8_STAGE(PG8_SB(0, 0), b2, voffB); PG8_STAGE(PG8_SB(0, 1), b2 + hstep, voffB); PG8_STAGE(PG8_SA(0, 0), a2, voffA);
            PG8_WAIT_V(8); PG8_WAIT_L(0); PG8_BAR; PG8_MMA(1, 0, At, B0); PG8_MMA(1, 1, At, B1); PG8_BAR; PG8_SCHED;
            PG8_LDB(B0, 1, 0); PG8_LDB(B1, 1, 1); PG8_SCHED; PG8_LDA(At, 1, 0); PG8_STAGE(PG8_SA(0, 1), a2 + hstepA, voffA);
            PG8_WAIT_V(8); PG8_WAIT_L(0); PG8_BAR; PG8_MMA(0, 0, At, B0); PG8_MMA(0, 1, At, B1); PG8_BAR; PG8_SCHED;
            PG8_LDA(At, 1, 1); PG8_STAGE(PG8_SB(1, 0), b3, voffB); PG8_STAGE(PG8_SB(1, 1), b3 + hstep, voffB); PG8_STAGE(PG8_SA(1, 0), a3, voffA);
            PG8_WAIT_V(8); PG8_WAIT_L(0); PG8_BAR; PG8_MMA(1, 0, At, B0); PG8_MMA(1, 1, At, B1); PG8_BAR; PG8_SCHED;
            } else {
            PG8_LDB(B0, 0, 0); PG8_SCHED; PG8_LDA(At, 0, 0); PG8_STAGE(PG8_SA(1, 1), a1 + hstepA, voffA);
            PG8_WAIT_L(8); PG8_BAR; PG8_WAIT_L(0); PG8_MMA(0, 0, At, B0); PG8_BAR; PG8_SCHED;
            PG8_LDB(B1, 0, 1); PG8_STAGE(PG8_SB(0, 0), b2, voffB);
            PG8_BAR; PG8_WAIT_L(0); PG8_MMA(0, 1, At, B1); PG8_BAR;
            PG8_LDA(At, 0, 1); PG8_STAGE(PG8_SA(0, 0), a2, voffA);
            PG8_BAR; PG8_WAIT_L(0); PG8_MMA(1, 0, At, B0); PG8_BAR; PG8_SCHED;
            PG8_STAGE(PG8_SB(0, 1), b2 + hstep, voffB);
            PG8_WAIT_V(6); PG8_BAR; PG8_MMA(1, 1, At, B1); PG8_BAR;
            PG8_LDB(B0, 1, 0); PG8_SCHED; PG8_LDA(At, 1, 0); PG8_STAGE(PG8_SA(0, 1), a2 + hstepA, voffA);
            PG8_WAIT_L(8); PG8_BAR; PG8_WAIT_L(0); PG8_MMA(0, 0, At, B0); PG8_BAR; PG8_SCHED;
            PG8_LDB(B1, 1, 1); PG8_STAGE(PG8_SB(1, 0), b3, voffB);
            PG8_BAR; PG8_WAIT_L(0); PG8_MMA(0, 1, At, B1); PG8_BAR;
            PG8_LDA(At, 1, 1); PG8_STAGE(PG8_SA(1, 0), a3, voffA);
            PG8_BAR; PG8_WAIT_L(0); PG8_MMA(1, 0, At, B0); PG8_BAR; PG8_SCHED;
            PG8_STAGE(PG8_SB(1, 1), b3 + hstep, voffB);
            PG8_WAIT_V(6); PG8_BAR; PG8_MMA(1, 1, At, B1); PG8_BAR;
            }
        }
        if constexpr (ALIGN_EPI) { if (wr == 0) PG8_BAR; }
        if constexpr (!Epi::AFTER_DRAIN) { E(acc, cur, wr, wc, fr, fq); S.done(cur); }
        if (!has_next) break;
#pragma unroll
        for (int a = 0; a < 2; ++a)
#pragma unroll
            for (int b = 0; b < 2; ++b)
#pragma unroll
                for (int m = 0; m < 4; ++m)
#pragma unroll
                    for (int n = 0; n < 2; ++n) acc[a][b][m][n] = (f32x4){0.f, 0.f, 0.f, 0.f};
        cur = nxt; cA = nA; cB = nB; ++ui;
        if constexpr (ALIGN_EPI) { if (wr == 1) PG8_BAR; }
    }
    PG8_WAIT_V(0);
    if constexpr (!ALIGN_EPI) { if (wr == 0) PG8_BAR; }
    PG8_BAR;
    if constexpr (Epi::AFTER_DRAIN) { E.fused(acc, cur, wr, wc, fr, fq, lds, wid, lane); S.done(cur); }
#undef PG8_SA
#undef PG8_SB
#undef PG8_STAGE
#undef PG8_LDA
#undef PG8_LDB
#undef PG8_MMA
#undef PG8_WAIT_V
#undef PG8_WAIT_L
#undef PG8_BAR
#undef PG8_SCHED
}
}

#define DI __device__ __forceinline__
#define LAS __attribute__((address_space(3)))
typedef unsigned short bf16_t;
typedef short bf16x8 __attribute__((ext_vector_type(8)));
typedef short s16x4 __attribute__((ext_vector_type(4)));
typedef float f32x4 __attribute__((ext_vector_type(4)));
typedef float f32x16 __attribute__((ext_vector_type(16)));
typedef unsigned u32x4 __attribute__((ext_vector_type(4)));
typedef unsigned u32x2 __attribute__((ext_vector_type(2)));

constexpr int NTOK = 16384, SEQ = 4096, DM = 2048, DFF = 5632, NU = 5376  , NLAYER = 2;
constexpr float EPS = 1e-6f, LOG2E = 1.4426950408889634f;
constexpr int U_CQ = 0, U_CKV = 512, U_KR = 768, U_DQ = 832, U_DK = 1344, U_DV = 1856, U_NQ = 2368, U_KC = 2880, U_VC = 3008, U_KS = 3136, U_VS = 3264,
              U_KW = 3392, U_VW = 3520, U_SQ = 3648, U_SK = 4160, U_SV = 4672, U_G = 5184;
constexpr size_t MiB = 1u << 20;
constexpr size_t W_GU1 = 0, W_D1 = 44 * MiB, W_IN = 66 * MiB, W_UQ = 87 * MiB, W_UKV = 88 * MiB, W_CK = 89 * MiB, W_CV = 90 * MiB, W_OUT = 92 * MiB, W_GU2 = 100 * MiB,
                 W_D2 = 144 * MiB, W_LAYER = 166 * MiB;
constexpr size_t WS_CTL = 0, WS_W = 1 * MiB, WS_XN = WS_W + 2 * W_LAYER  , WS_HID = WS_XN + 64 * MiB  ,
                 WS_QM = WS_HID + 176 * MiB  , WS_KM = WS_QM + 24 * MiB, WS_KVR = WS_KM + 24 * MiB, WS_VTM = WS_KVR + 32 * MiB, WS_VTD = WS_VTM + 16 * MiB,
                 WS_VTS = WS_VTD + 16 * MiB, WS_VTVS = WS_VTS + 16 * MiB, WS_VTVW = WS_VTVS + 4 * MiB, WS_AK = WS_VTVW + 4 * MiB, WS_AV = WS_AK + 8 * MiB,
                 WS_KC = WS_AV + 9 * MiB, WS_VCR = WS_KC + 1 * MiB, WS_VTVC = WS_VCR + 1 * MiB, WS_STASH = WS_VTVC + 1 * MiB  , WS_END = WS_STASH + 32 * MiB;
static_assert(WS_END <= 762 * MiB, "workspace map");

DI float bf2f(unsigned b) { return __uint_as_float(b << 16); }
typedef float f32x2_t __attribute__((ext_vector_type(2))); typedef __bf16 bf16x2_t __attribute__((ext_vector_type(2)));
DI unsigned pk2(float lo, float hi) { f32x2_t v = {lo, hi}; bf16x2_t b = __builtin_convertvector(v, bf16x2_t); return __builtin_bit_cast(unsigned, b); }
DI float wave_sum(float v) {
#pragma unroll
    for (int o = 1; o < 64; o <<= 1) v += __shfl_xor(v, o);
    return v; }
template <int W> DI float grp_sum(float v) {
#pragma unroll
    for (int o = 1; o < W; o <<= 1) v += __shfl_xor(v, o);
    return v; }
DI void ld8(const bf16_t* p, float (&f)[8]) { const u32x4 v = *(const u32x4*)p;
    f[0] = bf2f(v.x & 0xffffu); f[1] = bf2f(v.x >> 16); f[2] = bf2f(v.y & 0xffffu); f[3] = bf2f(v.y >> 16);
    f[4] = bf2f(v.z & 0xffffu); f[5] = bf2f(v.z >> 16); f[6] = bf2f(v.w & 0xffffu); f[7] = bf2f(v.w >> 16); }
DI void st8(bf16_t* p, const float (&f)[8]) { u32x4 w; w.x = pk2(f[0], f[1]); w.y = pk2(f[2], f[3]); w.z = pk2(f[4], f[5]); w.w = pk2(f[6], f[7]); *(u32x4*)p = w; }
DI float ssq8(const float (&f)[8]) { float s = 0.f;
#pragma unroll
    for (int e = 0; e < 8; ++e) s += f[e] * f[e];
    return s; }
DI int otid() { int t = (int)threadIdx.x; asm volatile("" : "+v"(t)); return t; }
#define LDS_WAIT() asm volatile("s_waitcnt lgkmcnt(0)" ::: "memory")

struct Args { const float* in[38]; float* out; unsigned char* ws; float inv_freq[32]; int ph_lo, ph_hi; };

struct Ctx {
    int layer; const Args* a; unsigned char* ws;
    DI unsigned char* wl() const { return ws + WS_W + (size_t)layer * W_LAYER; }
#define CTX_PTR(name, off) DI bf16_t* name() const { return (bf16_t*)(ws + (off)); }
    CTX_PTR(XN, WS_XN) CTX_PTR(MIX, WS_XN) CTX_PTR(HID, WS_HID) CTX_PTR(U, WS_HID) CTX_PTR(QM, WS_QM) CTX_PTR(KM, WS_KM) CTX_PTR(KVR, WS_KVR) CTX_PTR(VTM, WS_VTM)
    CTX_PTR(VTD, WS_VTD) CTX_PTR(VTS, WS_VTS) CTX_PTR(VTVS, WS_VTVS) CTX_PTR(VTVW, WS_VTVW) CTX_PTR(AK, WS_AK) CTX_PTR(AV, WS_AV) CTX_PTR(KC, WS_KC) CTX_PTR(VCR, WS_VCR)
    CTX_PTR(VTVC, WS_VTVC)
#undef CTX_PTR
};
DI Ctx make_ctx(const Args& a, int layer) { Ctx c; c.layer = layer; c.a = &a; c.ws = a.ws; return c; }

struct WDesc { const float* W; const float* gain; bf16_t* WT; int K, N, mode; float cscale; };
DI int wt_out_row(int mode, int c) {
    if (mode == 1) return 256 * (c >> 7) + (c & 127);
    if (mode == 2) return 256 * (c >> 7) + 128 + (c & 127);
    if (mode == 3) return c < 3648 ? c : (c < 3660 ? U_G + (c - 3648) : c - 12);
    return c;
}
DI void wt_item(const WDesc& d, LAS unsigned* scr, int item, int lane) {
    const int nblk = (d.N + 63) >> 6, kb = item / nblk, nb = item - kb * nblk, k0 = 64 * kb, n0 = 64 * nb;
    const int c = n0 + lane; const bool cv = c < d.N;
    float cs = 1.f; if (d.mode == 3 && c >= 3660 && c < 4172) cs = d.cscale;
    float wv[64];
    const float* wp = d.W + (size_t)k0 * d.N + (cv ? c : 0);
#pragma unroll
    for (int i = 0; i < 64; ++i) wv[i] = wp[(size_t)i * d.N];
#pragma unroll
    for (int jp = 0; jp < 32; ++jp) { float w0 = cv ? wv[2 * jp] : 0.f, w1 = cv ? wv[2 * jp + 1] : 0.f;
        if (d.gain) { w0 *= d.gain[k0 + 2 * jp]; w1 *= d.gain[k0 + 2 * jp + 1]; }
        scr[jp * 65 + lane] = pk2(w0 * cs, w1 * cs); }
    LDS_WAIT();
    const int ch = lane & 7, nl = lane >> 3;
#pragma unroll
    for (int jn = 0; jn < 8; ++jn) { const int n = nl + 8 * jn; const int cc = n0 + n;
        if (cc < d.N) { const LAS unsigned* sp = scr + (4 * ch) * 65 + n; u32x4 o; o.x = sp[0]; o.y = sp[65]; o.z = sp[130]; o.w = sp[195];
            *(u32x4*)(d.WT + (size_t)wt_out_row(d.mode, cc) * d.K + k0 + 8 * ch) = o; } }
    LDS_WAIT();
}
constexpr int WI_G = 32 * 88, WI_D = 88 * 32, WI_IN = 32 * 82, WI_UQ = 8 * 12, WI_UKV = 4 * 16, WI_C = 64 * 2, WI_OUT = 32 * 32;
constexpr int WI_LAYER = 6 * WI_G + WI_IN + WI_UQ + WI_UKV + 2 * WI_C + WI_OUT;
DI void p0_weights(const Args& a, LAS unsigned char* lds, int gw, int NGW, int wave, int lane) {
    LAS unsigned* scr = (LAS unsigned*)(lds + wave * 8704);
    for (int it = gw; it < NLAYER * WI_LAYER; it += NGW) {
        const int L = it / WI_LAYER; int r = it - L * WI_LAYER; unsigned char* wl = a.ws + WS_W + (size_t)L * W_LAYER;
        const size_t oDF = (size_t)L * DM * DFF, oD = (size_t)L * DM; WDesc d; d.cscale = 1.f; d.gain = nullptr;
        if (r < WI_G) { d = WDesc{a.in[2] + oDF, a.in[1] + oD, (bf16_t*)(wl + W_GU1), DM, DFF, 1, 1.f}; }
        else if ((r -= WI_G) < WI_G) { d = WDesc{a.in[3] + oDF, a.in[1] + oD, (bf16_t*)(wl + W_GU1), DM, DFF, 2, 1.f}; }
        else if ((r -= WI_G) < WI_D) { d = WDesc{a.in[4] + oDF, nullptr, (bf16_t*)(wl + W_D1), DFF, DM, 0, 1.f}; }
        else if ((r -= WI_D) < WI_IN) { d = WDesc{a.in[6] + (size_t)L * DM * 5196, a.in[5] + oD, (bf16_t*)(wl + W_IN), DM, 5196, 3, 0.08838834764831845f * LOG2E}; }
        else if ((r -= WI_IN) < WI_UQ) { d = WDesc{a.in[9] + (size_t)L * 512 * 768, a.in[7] + (size_t)L * 512, (bf16_t*)(wl + W_UQ), 512, 768, 0, 1.f}; }
        else if ((r -= WI_UQ) < WI_UKV) { d = WDesc{a.in[10] + (size_t)L * 256 * 1024, a.in[8] + (size_t)L * 256, (bf16_t*)(wl + W_UKV), 256, 1024, 0, 1.f}; }
        else if ((r -= WI_UKV) < WI_C) { d = WDesc{a.in[25] + (size_t)L * 4096 * 128, nullptr, (bf16_t*)(wl + W_CK), 4096, 128, 0, 1.f}; }
        else if ((r -= WI_C) < WI_C) { d = WDesc{a.in[27] + (size_t)L * 4096 * 128, nullptr, (bf16_t*)(wl + W_CV), 4096, 128, 0, 1.f}; }
        else if ((r -= WI_C) < WI_OUT) { d = WDesc{a.in[33] + (size_t)L * DM * DM, nullptr, (bf16_t*)(wl + W_OUT), DM, DM, 0, 1.f}; }
        else if ((r -= WI_OUT) < WI_G) { d = WDesc{a.in[35] + oDF, a.in[34] + oD, (bf16_t*)(wl + W_GU2), DM, DFF, 1, 1.f}; }
        else if ((r -= WI_G) < WI_G) { d = WDesc{a.in[36] + oDF, a.in[34] + oD, (bf16_t*)(wl + W_GU2), DM, DFF, 2, 1.f}; }
        else { r -= WI_G; d = WDesc{a.in[37] + oDF, nullptr, (bf16_t*)(wl + W_D2), DFF, DM, 0, 1.f}; }
        wt_item(d, scr, r, lane);
    }
}
DI void norm_rows(const float* src, bf16_t* xn, int gw, int NGW, int lane) {
    for (int m = gw; m < NTOK; m += NGW) {
        const f32x4* xr = (const f32x4*)(src + (size_t)m * DM) + lane; f32x4 v[8]; float s = 0.f;
#pragma unroll
        for (int j = 0; j < 8; ++j) { v[j] = xr[64 * j]; s += (v[j].x * v[j].x + v[j].y * v[j].y) + (v[j].z * v[j].z + v[j].w * v[j].w); }
        const float rstd = 1.0f / sqrtf(wave_sum(s) * (1.0f / DM) + EPS);
        u32x2* o = (u32x2*)(xn + (size_t)m * DM) + lane;
#pragma unroll
        for (int j = 0; j < 8; ++j) { u32x2 w; w.x = pk2(v[j].x * rstd, v[j].y * rstd); w.y = pk2(v[j].z * rstd, v[j].w * rstd); o[64 * j] = w; }
    }
}
DI void up8(const u32x4 v, float (&f)[8]) {
    f[0] = bf2f(v.x & 0xffffu); f[1] = bf2f(v.x >> 16); f[2] = bf2f(v.y & 0xffffu); f[3] = bf2f(v.y >> 16);
    f[4] = bf2f(v.z & 0xffffu); f[5] = bf2f(v.z >> 16); f[6] = bf2f(v.w & 0xffffu); f[7] = bf2f(v.w >> 16); }
DI void rope_cs(float ang, float& c, float& s) { const double rev = (double)ang * 0.15915494309189535; const float fr = (float)(rev - __builtin_rint(rev));
    s = __builtin_amdgcn_sinf(fr); c = __builtin_amdgcn_cosf(fr); }
DI void transpose64(const bf16_t* src_row, bf16_t* dst_lane, size_t dpitch) {
#pragma unroll
    for (int i = 0; i < 8; ++i) { const u32x4 v = *(const u32x4*)(src_row + 8 * i); bf16_t* d = dst_lane + (size_t)(8 * i) * dpitch;
        d[0] = (bf16_t)(v.x & 0xffffu); d[dpitch] = (bf16_t)(v.x >> 16); d[2 * dpitch] = (bf16_t)(v.y & 0xffffu); d[3 * dpitch] = (bf16_t)(v.y >> 16);
        d[4 * dpitch] = (bf16_t)(v.z & 0xffffu); d[5 * dpitch] = (bf16_t)(v.z >> 16); d[6 * dpitch] = (bf16_t)(v.w & 0xffffu); d[7 * dpitch] = (bf16_t)(v.w >> 16); }
}
DI void fix1(const Ctx& C, int gw, int NGW, int lane) {
    const Args& a = *C.a; const int L = C.layer;
    const float* kr_g = a.in[14] + L * 64; const float* dq_g = a.in[16] + L * 64; const float* dk_g = a.in[17] + L * 64; const float* nq_g = a.in[23] + L * 128;
    const float* pe_k = a.in[24] + L * 4096; const float* pe_v = a.in[26] + L * 4096; const float* ks_g = a.in[29] + L * 128; const float* kw_g = a.in[30] + L * 128;
    for (int m = gw; m < NTOK; m += NGW) {
        bf16_t* ur = C.U() + (size_t)m * NU; const int b = m >> 12, s = m & 4095; float f[8];
        const int off_kv = lane < 32 ? U_CKV + 8 * lane : U_KR + 8 * (lane & 7);
        const int off_ms = ((lane >> 4) == 0 ? U_KC : (lane >> 4) == 1 ? U_VC : (lane >> 4) == 2 ? U_KS : U_KW) + 8 * (lane & 15);
        const u32x4 r_cq = *(const u32x4*)(ur + U_CQ + 8 * lane), r_kv = *(const u32x4*)(ur + off_kv), r_dq = *(const u32x4*)(ur + U_DQ + 8 * lane),
                    r_dk = *(const u32x4*)(ur + U_DK + 8 * lane), r_nq = *(const u32x4*)(ur + U_NQ + 8 * lane), r_ms = *(const u32x4*)(ur + off_ms);
        { up8(r_cq, f); const float rstd = 1.0f / sqrtf(wave_sum(ssq8(f)) * (1.0f / 512) + EPS);
#pragma unroll
          for (int e = 0; e < 8; ++e) f[e] *= rstd;
          st8(ur + U_CQ + 8 * lane, f); }
        { const int off = off_kv; up8(r_kv, f); const float q = ssq8(f);
          const float tot = wave_sum(lane < 32 ? q : 0.f); const float kq = grp_sum<8>(q);
          float y[8], yp[8];
          const int li = lane & 7;
#pragma unroll
          for (int e = 0; e < 8; ++e) { y[e] = f[e] * (1.0f / sqrtf(kq * (1.0f / 64) + EPS)) * kr_g[8 * li + e]; }
#pragma unroll
          for (int e = 0; e < 8; ++e) yp[e] = __shfl_xor(y[e], 4);
          if (lane < 32) { const float rstd = 1.0f / sqrtf(tot * (1.0f / 256) + EPS);
#pragma unroll
              for (int e = 0; e < 8; ++e) f[e] *= rstd;
              st8(ur + off, f);
          } else if (lane < 40) { float o[8];
#pragma unroll
              for (int e = 0; e < 8; ++e) { float cs, sn; rope_cs((float)s * a.inv_freq[8 * (li & 3) + e], cs, sn); o[e] = (li < 4) ? y[e] * cs - yp[e] * sn : y[e] * cs + yp[e] * sn; }
#pragma unroll
              for (int hh = 0; hh < 4; ++hh) st8(C.KM() + (size_t)m * 768 + hh * 192 + 128 + 8 * li, o); } }
        { up8(r_dq, f); const float rstd = 1.0f / sqrtf(grp_sum<8>(ssq8(f)) * (1.0f / 64) + EPS) * (0.125f * LOG2E);
#pragma unroll
          for (int e = 0; e < 8; ++e) f[e] *= rstd * dq_g[8 * (lane & 7) + e];
          st8(ur + U_DQ + 8 * lane, f);
          up8(r_dk, f); const float rstd2 = 1.0f / sqrtf(grp_sum<8>(ssq8(f)) * (1.0f / 64) + EPS);
#pragma unroll
          for (int e = 0; e < 8; ++e) f[e] *= rstd2 * dk_g[8 * (lane & 7) + e];
          st8(ur + U_DK + 8 * lane, f); }
        { up8(r_nq, f); const float rstd = 1.0f / sqrtf(grp_sum<16>(ssq8(f)) * (1.0f / 128) + EPS) * (0.08838834764831845f * LOG2E);
#pragma unroll
          for (int e = 0; e < 8; ++e) f[e] *= rstd * nq_g[8 * (lane & 15) + e];
          st8(ur + U_NQ + 8 * lane, f); }
        { const int grp = lane >> 4, d0 = 8 * (lane & 15); const int off = off_ms; up8(r_ms, f);
          const float q = grp_sum<16>(ssq8(f));
          if (grp >= 2) { const float* g = grp == 2 ? ks_g : kw_g; const float rstd = 1.0f / sqrtf(q * (1.0f / 128) + EPS);
#pragma unroll
              for (int e = 0; e < 8; ++e) f[e] *= rstd * g[d0 + e];
              st8(ur + off, f);
          } else { const float* pe = grp == 0 ? pe_k : pe_v; bf16_t* A = grp == 0 ? C.AK() : C.AV(); const int n1 = s >> 4, li = s & 15; float o[8];
              if (n1 == 255) {
#pragma unroll
                  for (int e = 0; e < 8; ++e) o[e] = 0.f;
                  st8(A + (size_t)(b * 256 + 255) * 4096 + li * 128 + d0, o); st8(A + (size_t)(b * 256 + 255) * 4096 + (li + 16) * 128 + d0, o);
              } else {
#pragma unroll
                  for (int e = 0; e < 8; ++e) o[e] = f[e] + pe[li * 128 + d0 + e];
                  st8(A + (size_t)(b * 256 + n1) * 4096 + li * 128 + d0, o); }
              if (n1 >= 1) {
#pragma unroll
                  for (int e = 0; e < 8; ++e) o[e] = f[e] + pe[(li + 16) * 128 + d0 + e];
                  st8(A + (size_t)(b * 256 + n1 - 1) * 4096 + (li + 16) * 128 + d0, o); } } }
    }
    for (int it = gw; it < 256 * 19; it += NGW) { const int tg = it / 19, ch = it - tg * 19;     const int m = 64 * tg + lane, b = m >> 12, s = m & 4095;
        int col; bf16_t* dst;
        if (ch < 8) { col = U_DV + 64 * ch; dst = C.VTD() + ((size_t)(b * 4 + (ch >> 1)) * 128 + 64 * (ch & 1)) * SEQ; }
        else if (ch < 10) { col = U_VS + 64 * (ch - 8); dst = C.VTVS() + ((size_t)b * 128 + 64 * (ch - 8)) * SEQ; }
        else if (ch < 12) { col = U_VW + 64 * (ch - 10); dst = C.VTVW() + ((size_t)b * 128 + 64 * (ch - 10)) * SEQ; }
        else { const int c2 = ch - 12; col = U_SV + 64 * c2; dst = C.VTS() + ((size_t)(b * 4 + (c2 >> 1)) * 128 + 64 * (c2 & 1)) * SEQ; }
        transpose64(C.U() + (size_t)m * NU + col, dst + s, SEQ); }
}
DI void fix2(const Ctx& C, int gw, int NGW, int lane) {
    const Args& a = *C.a; const int L = C.layer;
    const float* qn_g = a.in[11] + L * 128; const float* qr_g = a.in[12] + L * 64; const float* kn_g = a.in[13] + L * 128; const float* kc_g = a.in[28] + L * 128;
    const float qscale = 0.07216878364870322f * LOG2E;
    for (int m = gw; m < NTOK; m += NGW) { const int s = m & 4095; float f[8];
        bf16_t* qr = C.QM() + (size_t)m * 768;
        const u32x4 r_qn = *(const u32x4*)(qr + (lane >> 4) * 192 + 8 * (lane & 15)), r_qr = *(const u32x4*)(qr + ((lane & 31) >> 3) * 192 + 128 + 8 * (lane & 7)),
                    r_kn = *(const u32x4*)(C.KVR() + (size_t)m * 1024 + (lane >> 4) * 256 + 8 * (lane & 15));
        { const int hd = lane >> 4, d0 = 8 * (lane & 15); up8(r_qn, f); const float rstd = 1.0f / sqrtf(grp_sum<16>(ssq8(f)) * (1.0f / 128) + EPS) * qscale;
#pragma unroll
          for (int e = 0; e < 8; ++e) f[e] *= rstd * qn_g[d0 + e];
          st8(qr + hd * 192 + d0, f); }
        { const int l5 = lane & 31, hd = l5 >> 3, li = l5 & 7; up8(r_qr, f); const float rstd = 1.0f / sqrtf(grp_sum<8>(ssq8(f)) * (1.0f / 64) + EPS);
          float y[8], yp[8], o[8];
#pragma unroll
          for (int e = 0; e < 8; ++e) y[e] = f[e] * rstd * qr_g[8 * li + e];
#pragma unroll
          for (int e = 0; e < 8; ++e) yp[e] = __shfl_xor(y[e], 4);
#pragma unroll
          for (int e = 0; e < 8; ++e) { float cs, sn; rope_cs((float)s * a.inv_freq[8 * (li & 3) + e], cs, sn); o[e] = ((li < 4) ? y[e] * cs - yp[e] * sn : y[e] * cs + yp[e] * sn) * qscale; }
          if (lane < 32) st8(qr + hd * 192 + 128 + 8 * li, o); }
        { const int hd = lane >> 4, d0 = 8 * (lane & 15); up8(r_kn, f); const float rstd = 1.0f / sqrtf(grp_sum<16>(ssq8(f)) * (1.0f / 128) + EPS);
#pragma unroll
          for (int e = 0; e < 8; ++e) f[e] *= rstd * kn_g[d0 + e];
          st8(C.KM() + (size_t)m * 768 + hd * 192 + d0, f); }
    }
    for (int r4 = gw; r4 < 256; r4 += NGW) { const int row = 4 * r4 + (lane >> 4), d0 = 8 * (lane & 15); float f[8]; ld8(C.KC() + (size_t)row * 128 + d0, f);
        const float rstd = 1.0f / sqrtf(grp_sum<16>(ssq8(f)) * (1.0f / 128) + EPS);
#pragma unroll
        for (int e = 0; e < 8; ++e) f[e] *= rstd * kc_g[d0 + e];
        st8(C.KC() + (size_t)row * 128 + d0, f); }
    for (int it = gw; it < 256 * 8 + 32 + 256; it += NGW) {
        if (it >= 2080) { const int tg = it - 2080; const int m = 64 * tg + lane, b = m >> 12, s = m & 4095;
            transpose64(C.U() + (size_t)m * NU + 5120, C.VTS() + ((size_t)(b * 4 + 3) * 128 + 64) * SEQ + s, SEQ);
        } else if (it < 2048) { const int tg = it >> 3, ch = it & 7; const int m = 64 * tg + lane, b = m >> 12, s = m & 4095;
            transpose64(C.KVR() + (size_t)m * 1024 + (ch >> 1) * 256 + 128 + 64 * (ch & 1), C.VTM() + ((size_t)(b * 4 + (ch >> 1)) * 128 + 64 * (ch & 1)) * SEQ + s, SEQ);
        } else { const int i2 = it - 2048, rg = i2 >> 1, ch = i2 & 1; const int row = 64 * rg + lane, b = row >> 8, n = row & 255;
            transpose64(C.VCR() + (size_t)row * 128 + 64 * ch, C.VTVC() + ((size_t)b * 128 + 64 * ch) * 256 + n, 256); }
    }
}

namespace att {
constexpr float NEG = -1e30f;
constexpr int VP = 72;
constexpr int OFF_K = 0, OFF_V = 25600, OFF_WS = OFF_V + 128 * VP * 2  , OFF_IMP = OFF_WS + 8 * 256  , OFF_SEL = OFF_IMP + 65536  ,
              OFF_MISC = OFF_SEL + 512  , LDS_END = OFF_MISC + 64;
DI int crow(int reg, int h) { return (reg & 3) + 8 * (reg >> 2) + 4 * h; }
#define MFMA32(a, b, c) __builtin_amdgcn_mfma_f32_32x32x16_bf16((a), (b), (c), 0, 0, 0)

struct Pre { u32x4 k[3]; u32x4 v[2]; };
template <int DK> DI void prefetch(int tid, Pre& P, const bf16_t* kg, size_t kpitch, const bf16_t* vg, size_t vpitch, bool with_v) {
    constexpr int PPR = DK / 8;
#pragma unroll
    for (int i = 0; i < (64 * PPR) / 512; ++i) { const int p = tid + i * 512; const int r = p / PPR, c = p - r * PPR; P.k[i] = *(const u32x4*)(kg + (size_t)r * kpitch + c * 8); }
    if (with_v) {
#pragma unroll
        for (int i = 0; i < 2; ++i) { const int p = tid + i * 512; const int r = p >> 3, c = p & 7; P.v[i] = *(const u32x4*)(vg + (size_t)r * vpitch + c * 8); } }
}
template <int DK> DI void commit(int tid, const Pre& P, LAS unsigned char* lds, bool with_v) {
    constexpr int PPR = DK / 8, KP = DK + 8;
#pragma unroll
    for (int i = 0; i < (64 * PPR) / 512; ++i) { const int p = tid + i * 512; const int r = p / PPR, c = p - r * PPR; *(LAS u32x4*)(lds + OFF_K + (r * KP + c * 8) * 2) = P.k[i]; }
    if (with_v) {
#pragma unroll
        for (int i = 0; i < 2; ++i) { const int p = tid + i * 512; const int r = p >> 3, c = p & 7; *(LAS u32x4*)(lds + OFF_V + (r * VP + c * 8) * 2) = P.v[i]; } }
}
template <int DK> DI void qk(f32x16& p0, f32x16& p1, const LAS unsigned char* lds, const bf16x8 (&qf)[DK / 16], int r, int h, float slope2 = 0.f, float b0 = 0.f) {
    constexpr int KP = DK + 8;
    const LAS unsigned char* k0 = lds + OFF_K + (r * KP + 8 * h) * 2; const LAS unsigned char* k1 = k0 + 32 * KP * 2;
#pragma unroll
    for (int e = 0; e < 16; ++e) { p0[e] = fmaf(slope2, (float)((e & 3) + 8 * (e >> 2)), b0); p1[e] = fmaf(slope2, (float)((e & 3) + 8 * (e >> 2) + 32), b0); }
#pragma unroll
    for (int ks = 0; ks < DK / 16; ++ks) { const bf16x8 a0 = *(const LAS bf16x8*)(k0 + ks * 32); const bf16x8 a1 = *(const LAS bf16x8*)(k1 + ks * 32);
        p0 = MFMA32(a0, qf[ks], p0); p1 = MFMA32(a1, qf[ks], p1); }
}
DI bf16x8 pack8(const f32x16& x, int s) {
    u32x4 p; p.x = pk2(x[8 * s], x[8 * s + 1]); p.y = pk2(x[8 * s + 2], x[8 * s + 3]); p.z = pk2(x[8 * s + 4], x[8 * s + 5]); p.w = pk2(x[8 * s + 6], x[8 * s + 7]);
    return __builtin_bit_cast(bf16x8, p); }
DI void pv(f32x16 (&o)[4], const f32x16& p0, const f32x16& p1, const LAS unsigned char* lds, int r, int h) {
    const LAS unsigned char* vb = lds + OFF_V + (r * VP + 4 * h) * 2;
#pragma unroll
    for (int sp = 0; sp < 4; ++sp) { const bf16x8 pa = (sp < 2) ? pack8(p0, sp & 1) : pack8(p1, sp & 1);
#pragma unroll
        for (int db = 0; db < 4; ++db) { const LAS unsigned char* vr = vb + db * 32 * VP * 2 + sp * 32;
            const s16x4 lo = *(const LAS s16x4*)(vr); const s16x4 hi = *(const LAS s16x4*)(vr + 16);
            const bf16x8 vv = __builtin_shufflevector(lo, hi, 0, 1, 2, 3, 4, 5, 6, 7);
            o[db] = MFMA32(pa, vv, o[db]); } }
}
DI void scale_rows(f32x16 (&o)[4], float fac, LAS float* wsf, int r, int h) {
    if (h == 0) wsf[r] = fac;
    LDS_WAIT(); __builtin_amdgcn_wave_barrier();
#pragma unroll
    for (int g = 0; g < 4; ++g) { const f32x4 f4 = *(const LAS f32x4*)(wsf + 8 * g + 4 * h);
#pragma unroll
        for (int db = 0; db < 4; ++db) { o[db][4 * g] *= f4.x; o[db][4 * g + 1] *= f4.y; o[db][4 * g + 2] *= f4.z; o[db][4 * g + 3] *= f4.w; } }
    LDS_WAIT(); __builtin_amdgcn_wave_barrier();
}
DI void stash_store(float* st, const f32x16 (&o)[4], int tid) { f32x4* p = (f32x4*)(st + tid * 64);
#pragma unroll
    for (int db = 0; db < 4; ++db)
#pragma unroll
        for (int g = 0; g < 4; ++g) p[db * 4 + g] = (f32x4){o[db][4 * g], o[db][4 * g + 1], o[db][4 * g + 2], o[db][4 * g + 3]}; }
DI void stash_add(const float* st, f32x16 (&o)[4], int tid) { const f32x4* p = (const f32x4*)(st + tid * 64);
#pragma unroll
    for (int db = 0; db < 4; ++db)
#pragma unroll
        for (int g = 0; g < 4; ++g) { const f32x4 v = p[db * 4 + g]; o[db][4 * g] += v.x; o[db][4 * g + 1] += v.y; o[db][4 * g + 2] += v.z; o[db][4 * g + 3] += v.w; } }
DI float max32(const f32x16& p0, const f32x16& p1) { float a = fmaxf(p0[0], p1[0]);
#pragma unroll
    for (int e = 1; e < 16; ++e) a = fmaxf(a, fmaxf(p0[e], p1[e]));
    return fmaxf(a, __shfl_xor(a, 32)); }
DI void softmax_step(f32x16& p0, f32x16& p1, float& m, float& l, f32x16 (&o)[4], LAS float* wsf, int r, int h, bool has_o) {
    const float mn = fmaxf(m, max32(p0, p1)); const float mu = (mn < 0.5f * NEG) ? 0.f : mn; const float f = __builtin_amdgcn_exp2f(m - mu);
    float s = 0.f;
#pragma unroll
    for (int e = 0; e < 16; ++e) { p0[e] = __builtin_amdgcn_exp2f(p0[e] - mu); p1[e] = __builtin_amdgcn_exp2f(p1[e] - mu); s += p0[e] + p1[e]; }
    l = l * f + s; m = mn;
    if (has_o && __any(f != 1.0f)) scale_rows(o, f, wsf, r, h);
}
DI void finish_write(const f32x16 (&o)[4], const float* gain, float extra, bf16_t* out, size_t pitch, int r, int h) {
    float g[4];
#pragma unroll
    for (int db = 0; db < 4; ++db) g[db] = gain[r + 32 * db] * extra;
#pragma unroll
    for (int reg = 0; reg < 16; ++reg) { float ss = o[0][reg] * o[0][reg] + o[1][reg] * o[1][reg] + o[2][reg] * o[2][reg] + o[3][reg] * o[3][reg];
        ss += __shfl_xor(ss, 1); ss += __shfl_xor(ss, 2); ss += __shfl_xor(ss, 4); ss += __shfl_xor(ss, 8); ss += __shfl_xor(ss, 16);
        const float rstd = 1.0f / sqrtf(ss * (1.0f / 128) + EPS); bf16_t* orow = out + (size_t)crow(reg, h) * pitch + r;
#pragma unroll
        for (int db = 0; db < 4; ++db) orow[32 * db] = (bf16_t)(pk2(o[db][reg] * rstd * g[db], 0.f) & 0xffffu); }
}
DI void zero_o(f32x16 (&o)[4]) {
#pragma unroll
    for (int db = 0; db < 4; ++db)
#pragma unroll
        for (int e = 0; e < 16; ++e) o[db][e] = 0.f; }
DI void causal_mask(f32x16& p0, f32x16& p1, int kv0, int t, int h) {
    const int d0 = kv0 + 4 * h - t;
#pragma unroll
    for (int e = 0; e < 16; ++e) { const int dk = d0 + (e & 3) + 8 * (e >> 2); if (dk > 0) p0[e] = NEG; if (dk + 32 > 0) p1[e] = NEG; }
}
DI void unit_mla(LAS unsigned char* lds, const Ctx& C, int b, int hd, int qb) {
    const int tid = otid(), lane = tid & 63, w = __builtin_amdgcn_readfirstlane(tid >> 6), r = lane & 31, h = lane >> 5;
    LAS float* wsf = (LAS float*)(lds + OFF_WS + w * 256);
    const int t0 = qb * 256 + w * 32, t = t0 + r; const size_t tok = (size_t)b * SEQ + t;
    bf16x8 qf[12];
#pragma unroll
    for (int ks = 0; ks < 12; ++ks) qf[ks] = *(const bf16x8*)(C.QM() + tok * 768 + hd * 192 + 16 * ks + 8 * h);
    const bf16_t* kbase = C.KM() + (size_t)b * SEQ * 768 + hd * 192; const bf16_t* vbase = C.VTM() + (size_t)((b * 4 + hd) * 128) * SEQ;
    f32x16 o[4]; zero_o(o); float m = NEG, l = 0.f; const int nt = 4 * qb + 4;
    Pre P; prefetch<192>(tid, P, kbase, 768, vbase, SEQ, true);
    for (int j = 0; j < nt; ++j) {
        __syncthreads(); commit<192>(tid, P, lds, true); __syncthreads();
        if (j + 1 < nt) prefetch<192>(tid, P, kbase + (size_t)(j + 1) * 64 * 768, 768, vbase + (j + 1) * 64, SEQ, true);
        const int kv0 = 64 * j;
        if (kv0 <= t0 + 31) { f32x16 p0, p1; qk<192>(p0, p1, lds, qf, r, h);
            if (kv0 + 63 > t0) causal_mask(p0, p1, kv0, t, h);
            softmax_step(p0, p1, m, l, o, wsf, r, h, true); pv(o, p0, p1, lds, r, h); }
    }
    l += __shfl_xor(l, 32); scale_rows(o, 1.0f / fmaxf(l, 1e-30f), wsf, r, h);
    finish_write(o, C.a->in[15] + C.layer * 128, 1.f, C.MIX() + ((size_t)b * SEQ + t0) * DM + hd * 128, DM, r, h);
}
DI bool diff_fixed_ok(const Ctx& C) { const int lane = otid() & 63; const Args& a = *C.a; float gq = fabsf(a.in[16][C.layer * 64 + lane]), gk = fabsf(a.in[17][C.layer * 64 + lane]);
#pragma unroll
    for (int of = 1; of < 64; of <<= 1) { gq = fmaxf(gq, __shfl_xor(gq, of)); gk = fmaxf(gk, __shfl_xor(gk, of)); }
    return __builtin_amdgcn_readfirstlane((8.1f * gq * 0.125f * LOG2E) * (8.1f * gk) < 45.0f ? 1 : 0) != 0; }
template <bool FIXED> DI void unit_diff(LAS unsigned char* lds, const Ctx& C, int b, int hd, int qb) {
    const int tid = otid(), lane = tid & 63, w = __builtin_amdgcn_readfirstlane(tid >> 6), r = lane & 31, h = lane >> 5;
    LAS float* wsf = (LAS float*)(lds + OFF_WS + w * 256); const Args& a = *C.a; const int L = C.layer;
    LAS int* votes = (LAS int*)(lds + OFF_MISC + 16);
    const float lam_init = 0.8f - 0.6f * expf(-0.3f * (float)L);
    const float lam = expf(wave_sum(a.in[18][L * 64 + lane] * a.in[19][L * 64 + lane])) - expf(wave_sum(a.in[20][L * 64 + lane] * a.in[21][L * 64 + lane])) + lam_init;
    const float slope2 = exp2f(-(float)(2 * hd + 1)) * LOG2E;
    float kmax = fabsf(a.in[17][L * 64 + lane]);
#pragma unroll
    for (int of = 1; of < 64; of <<= 1) kmax = fmaxf(kmax, __shfl_xor(kmax, of));
    kmax *= 8.1f;
    const int t0 = qb * 256 + w * 32, t = t0 + r; const size_t tok = (size_t)b * SEQ + t;
    const bf16_t* vbase = C.VTD() + (size_t)((b * 4 + hd) * 128) * SEQ;
    float* stash = (float*)(C.ws + WS_STASH) + (size_t)blockIdx.x * 32768; const int nt = 4 * qb + 4;
    f32x16 o[4];
#pragma unroll 1
    for (int which = 0; which < 2; ++which) {
        bf16x8 qf[4]; float qn = 0.f;
#pragma unroll
        for (int ks = 0; ks < 4; ++ks) { qf[ks] = *(const bf16x8*)(C.U() + tok * NU + U_DQ + hd * 128 + which * 64 + 16 * ks + 8 * h);
#pragma unroll
            for (int e = 0; e < 8; ++e) { const float x = bf2f((unsigned)(unsigned short)qf[ks][e]); qn += x * x; } }
        qn += __shfl_xor(qn, 32); const float bq = sqrtf(qn) * kmax;
        const bf16_t* kbase = C.U() + (size_t)b * SEQ * NU + U_DK + hd * 128 + which * 64;
        zero_o(o); float m = NEG, l = 0.f;
        Pre P; prefetch<64>(tid, P, kbase + (size_t)(nt - 1) * 64 * NU, NU, vbase + (nt - 1) * 64, SEQ, true);
        for (int j = nt - 1; j >= 0; --j) {
            __syncthreads();
            if (j < nt - 1) { int alld = 1;
#pragma unroll
                for (int i = 0; i < 8; ++i) alld &= votes[i];
                if (__builtin_amdgcn_readfirstlane(alld)) break; }
            commit<64>(tid, P, lds, true); __syncthreads();
            if (j > 0) prefetch<64>(tid, P, kbase + (size_t)(j - 1) * 64 * NU, NU, vbase + (j - 1) * 64, SEQ, true);
            const int kv0 = 64 * j;
            if (kv0 <= t0 + 31) { f32x16 p0, p1; qk<64>(p0, p1, lds, qf, r, h, slope2, slope2 * (float)(kv0 + 4 * h - t) - (FIXED ? bq : 0.f));
                if (kv0 + 63 > t0) causal_mask(p0, p1, kv0, t, h);
                if constexpr (FIXED) {
                    float sacc = 0.f;
#pragma unroll
                    for (int e = 0; e < 16; ++e) { p0[e] = __builtin_amdgcn_exp2f(p0[e]); p1[e] = __builtin_amdgcn_exp2f(p1[e]); sacc += p0[e] + p1[e]; }
                    l += sacc; m = bq;
                } else softmax_step(p0, p1, m, l, o, wsf, r, h, true);
                pv(o, p0, p1, lds, r, h); }
            { const bool dn = (m > 0.5f * NEG) && (bq - slope2 * (float)(t - kv0 + 1) - m < -160.0f); const int av = __all(dn) ? 1 : 0; if (lane == 0) votes[w] = av; }
        }
        l += __shfl_xor(l, 32); scale_rows(o, (which == 0 ? 1.0f : -lam) / fmaxf(l, 1e-30f), wsf, r, h);
        if (which == 0) stash_store(stash, o, tid); else stash_add(stash, o, tid);
    }
    finish_write(o, a.in[22] + L * 128, 1.0f - lam_init, C.MIX() + ((size_t)b * SEQ + t0) * DM + 512 + hd * 128, DM, r, h);
}
DI float softplus2(float z) { return fmaxf(z, 0.f) + __builtin_amdgcn_logf(1.0f + __builtin_amdgcn_exp2f(-fabsf(z))); }
DI void unit_sb(LAS unsigned char* lds, const Ctx& C, int b, int hd, int qb) {
    const int tid = otid(), lane = tid & 63, w = __builtin_amdgcn_readfirstlane(tid >> 6), r = lane & 31, h = lane >> 5;
    const int t0 = qb * 256 + w * 32, t = t0 + r; const size_t tok = (size_t)b * SEQ + t;
    bf16x8 qf[8];
#pragma unroll
    for (int ks = 0; ks < 8; ++ks) qf[ks] = *(const bf16x8*)(C.U() + tok * NU + U_SQ + hd * 128 + 16 * ks + 8 * h);
    const bf16_t* kbase = C.U() + (size_t)b * SEQ * NU + U_SK + hd * 128; const bf16_t* vbase = C.VTS() + (size_t)((b * 4 + hd) * 128) * SEQ;
    f32x16 o[4]; zero_o(o); float cum = 0.f;
    const int nt = 4 * qb + 4;
    Pre P; prefetch<128>(tid, P, kbase + (size_t)(nt - 1) * 64 * NU, NU, vbase + (nt - 1) * 64, SEQ, true);
    LAS int* votes = (LAS int*)(lds + OFF_MISC + 16);
    for (int j = nt - 1; j >= 0; --j) {
        __syncthreads();
        if (j < nt - 1) { int alld = 1;
#pragma unroll
            for (int i = 0; i < 8; ++i) alld &= votes[i];
            if (__builtin_amdgcn_readfirstlane(alld)) break; }
        commit<128>(tid, P, lds, true); __syncthreads();
        if (j > 0) prefetch<128>(tid, P, kbase + (size_t)(j - 1) * 64 * NU, NU, vbase + (j - 1) * 64, SEQ, true);
        const int kv0 = 64 * j;
        if (kv0 < t0 + 31) { f32x16 p0, p1; qk<128>(p0, p1, lds, qf, r, h);
            const int d0 = kv0 + 4 * h - t; f32x16 s0, s1;
#pragma unroll
            for (int e = 0; e < 16; ++e) { const int dk = d0 + (e & 3) + 8 * (e >> 2); s0[e] = (dk < 0) ? softplus2(p0[e]) : 0.f; s1[e] = (dk + 32 < 0) ? softplus2(p1[e]) : 0.f; }
            float Gs[8], Go[8];
#pragma unroll
            for (int k = 0; k < 4; ++k) { Gs[k] = (s0[4 * k] + s0[4 * k + 1]) + (s0[4 * k + 2] + s0[4 * k + 3]); Gs[k + 4] = (s1[4 * k] + s1[4 * k + 1]) + (s1[4 * k + 2] + s1[4 * k + 3]); }
#pragma unroll
            for (int k = 0; k < 8; ++k) Go[k] = __shfl_xor(Gs[k], 32);
            float T = 0.f;
#pragma unroll
            for (int k = 7; k >= 0; --k) { float base = cum - T - (h == 0 ? Go[k] : 0.f);
                if (k < 4) {
                    float e3 = base;            float e2 = e3 - s0[4 * k + 3]; float e1 = e2 - s0[4 * k + 2]; float e0 = e1 - s0[4 * k + 1];
                    const int dk = d0 + 8 * k;
                    p0[4 * k + 3] = (dk + 3 < 0) ? __builtin_amdgcn_exp2f(p0[4 * k + 3] - s0[4 * k + 3] + e3) : 0.f;
                    p0[4 * k + 2] = (dk + 2 < 0) ? __builtin_amdgcn_exp2f(p0[4 * k + 2] - s0[4 * k + 2] + e2) : 0.f;
                    p0[4 * k + 1] = (dk + 1 < 0) ? __builtin_amdgcn_exp2f(p0[4 * k + 1] - s0[4 * k + 1] + e1) : 0.f;
                    p0[4 * k + 0] = (dk + 0 < 0) ? __builtin_amdgcn_exp2f(p0[4 * k + 0] - s0[4 * k + 0] + e0) : 0.f;
                } else { const int kk = k - 4;
                    float e3 = base;            float e2 = e3 - s1[4 * kk + 3]; float e1 = e2 - s1[4 * kk + 2]; float e0 = e1 - s1[4 * kk + 1];
                    const int dk = d0 + 8 * k;
                    p1[4 * kk + 3] = (dk + 3 < 0) ? __builtin_amdgcn_exp2f(p1[4 * kk + 3] - s1[4 * kk + 3] + e3) : 0.f;
                    p1[4 * kk + 2] = (dk + 2 < 0) ? __builtin_amdgcn_exp2f(p1[4 * kk + 2] - s1[4 * kk + 2] + e2) : 0.f;
                    p1[4 * kk + 1] = (dk + 1 < 0) ? __builtin_amdgcn_exp2f(p1[4 * kk + 1] - s1[4 * kk + 1] + e1) : 0.f;
                    p1[4 * kk + 0] = (dk + 0 < 0) ? __builtin_amdgcn_exp2f(p1[4 * kk + 0] - s1[4 * kk + 0] + e0) : 0.f; }
                T += Gs[k] + Go[k]; }
            cum -= T;
            pv(o, p0, p1, lds, r, h); }
        { const int dn = __all(cum < -160.0f) ? 1 : 0; if (lane == 0) votes[w] = dn; }
    }
    finish_write(o, C.a->in[32] + C.layer * 128, 1.f, C.MIX() + ((size_t)b * SEQ + t0) * DM + 1536 + hd * 128, DM, r, h);
}
DI void cmp_bias_mask(f32x16& p0, f32x16& p1, int n0, int t, int h, float slope2) {
    const int c0 = 16 * (n0 + 4 * h) + 31 - t;
#pragma unroll
    for (int e = 0; e < 16; ++e) { const int ce = c0 + 16 * ((e & 3) + 8 * (e >> 2));
        p0[e] = (ce > 0) ? NEG : fmaf(slope2, (float)ce, p0[e]); p1[e] = (ce + 512 > 0) ? NEG : fmaf(slope2, (float)(ce + 512), p1[e]); }
}
DI void unit_nsa(LAS unsigned char* lds, const Ctx& C, int b, int qb) {
    const int tid = otid(), lane = tid & 63, w = __builtin_amdgcn_readfirstlane(tid >> 6), r = lane & 31, h = lane >> 5, hd = w >> 1, qh = w & 1;
    LAS float* wsf = (LAS float*)(lds + OFF_WS + w * 256); LAS float* imp = (LAS float*)(lds + OFF_IMP); LAS unsigned long long* sel = (LAS unsigned long long*)(lds + OFF_SEL);
    const int t0 = qb * 64 + qh * 32, t = t0 + r, ql = qh * 32 + r; const size_t tok = (size_t)b * SEQ + t;
    bf16x8 qf[8];
#pragma unroll
    for (int ks = 0; ks < 8; ++ks) qf[ks] = *(const bf16x8*)(C.U() + tok * NU + U_NQ + hd * 128 + 16 * ks + 8 * h);
    const bf16_t* gp = C.U() + tok * NU + U_G + hd * 3;
    const float g0 = 1.0f / (1.0f + __expf(-bf2f(gp[0]))), g1 = 1.0f / (1.0f + __expf(-bf2f(gp[1]))), g2 = 1.0f / (1.0f + __expf(-bf2f(gp[2])));
    const float slope2 = exp2f(-(float)(2 * hd + 2)) * LOG2E;
    for (int i = tid; i < 16384; i += 512) imp[i] = 0.f;
    float* stash = (float*)(C.ws + WS_STASH) + (size_t)blockIdx.x * 32768; f32x16 o[4]; Pre P;
    const bf16_t* kcb = C.KC() + (size_t)b * 256 * 128; const bf16_t* vcb = C.VTVC() + (size_t)b * 128 * 256; const int ntc = (4 * qb + 2) / 64 + 1;
    float m = NEG, l = 0.f;
    prefetch<128>(tid, P, kcb, 128, vcb, 256, false);
    for (int j = 0; j < ntc; ++j) {
        __syncthreads(); commit<128>(tid, P, lds, false); __syncthreads();
        if (j + 1 < ntc) prefetch<128>(tid, P, kcb + (size_t)(j + 1) * 64 * 128, 128, vcb, 256, false);
        f32x16 p0, p1; qk<128>(p0, p1, lds, qf, r, h); cmp_bias_mask(p0, p1, 64 * j, t, h, slope2); softmax_step(p0, p1, m, l, o, wsf, r, h, false);
    }
    l += __shfl_xor(l, 32);
    { const float mu = (m < 0.5f * NEG) ? 0.f : m; const float il = 1.0f / fmaxf(l, 1e-30f);
      zero_o(o); prefetch<128>(tid, P, kcb, 128, vcb, 256, true);
      for (int j = 0; j < ntc; ++j) {
          __syncthreads(); commit<128>(tid, P, lds, true); __syncthreads();
          if (j + 1 < ntc) prefetch<128>(tid, P, kcb + (size_t)(j + 1) * 64 * 128, 128, vcb + (j + 1) * 64, 256, true);
          f32x16 p0, p1; qk<128>(p0, p1, lds, qf, r, h); cmp_bias_mask(p0, p1, 64 * j, t, h, slope2);
#pragma unroll
          for (int e = 0; e < 16; ++e) { p0[e] = __builtin_amdgcn_exp2f(p0[e] - mu) * il; p1[e] = __builtin_amdgcn_exp2f(p1[e] - mu) * il; }
#pragma unroll
          for (int g = 0; g < 4; ++g) { const int jb = 16 * j + 2 * g + h; LAS float* ip = imp + hd * 4096 + ql * 64 + jb;
              __hip_atomic_fetch_add(ip, (p0[4 * g] + p0[4 * g + 1]) + (p0[4 * g + 2] + p0[4 * g + 3]), __ATOMIC_RELAXED, __HIP_MEMORY_SCOPE_WORKGROUP);
              __hip_atomic_fetch_add(ip + 1, p0[4 * g + 3], __ATOMIC_RELAXED, __HIP_MEMORY_SCOPE_WORKGROUP);
              __hip_atomic_fetch_add(ip + 8, (p1[4 * g] + p1[4 * g + 1]) + (p1[4 * g + 2] + p1[4 * g + 3]), __ATOMIC_RELAXED, __HIP_MEMORY_SCOPE_WORKGROUP);
              if (jb + 9 < 64) __hip_atomic_fetch_add(ip + 9, p1[4 * g + 3], __ATOMIC_RELAXED, __HIP_MEMORY_SCOPE_WORKGROUP); }
          pv(o, p0, p1, lds, r, h);
      }
      scale_rows(o, g0, wsf, r, h); stash_store(stash, o, tid); }
    __syncthreads();
    for (int qi = 0; qi < 8; ++qi) { const int q = 8 * w + qi; const float v = ((imp[q * 64 + lane] + imp[4096 + q * 64 + lane]) + imp[8192 + q * 64 + lane]) + imp[12288 + q * 64 + lane];
        const bool valid = lane <= qb, forced = (lane == 0) || (lane == qb) || (lane == qb - 1); const float key = forced ? 3.0e38f : v; int rank = 0;
        for (int jj = 0; jj <= qb; ++jj) { const float kj = __shfl(key, jj); rank += ((kj > key) || (kj == key && jj < lane)) ? 1 : 0; }
        const unsigned long long mk = __ballot(valid && rank < 16);
        if (lane == 0) sel[q] = mk; }
    __syncthreads();
    const unsigned long long selq = sel[ql];
    unsigned long long un;
    { unsigned long long u = sel[lane]; unsigned lo = (unsigned)u, hi = (unsigned)(u >> 32);
#pragma unroll
      for (int of = 1; of < 64; of <<= 1) { lo |= __shfl_xor(lo, of); hi |= __shfl_xor(hi, of); }
      un = ((unsigned long long)(unsigned)__builtin_amdgcn_readfirstlane((int)hi) << 32) | (unsigned long long)(unsigned)__builtin_amdgcn_readfirstlane((int)lo); }
    { const bf16_t* kb = C.U() + (size_t)b * SEQ * NU + U_KS; const bf16_t* vb = C.VTVS() + (size_t)b * 128 * SEQ;
      m = NEG; l = 0.f; zero_o(o); unsigned long long rem = un;
      if (rem) { const int j0 = __builtin_ctzll(rem); prefetch<128>(tid, P, kb + (size_t)j0 * 64 * NU, NU, vb + j0 * 64, SEQ, true); }
      while (rem) { const int j = __builtin_ctzll(rem); rem &= rem - 1;
          __syncthreads(); commit<128>(tid, P, lds, true); __syncthreads();
          if (rem) { const int jn = __builtin_ctzll(rem); prefetch<128>(tid, P, kb + (size_t)jn * 64 * NU, NU, vb + jn * 64, SEQ, true); }
          const bool mine = (selq >> j) & 1ull;
          if (__any(mine)) { f32x16 p0, p1; qk<128>(p0, p1, lds, qf, r, h, slope2, slope2 * (float)(64 * j + 4 * h - t)); if (64 * j + 63 > t0) causal_mask(p0, p1, 64 * j, t, h);
              if (!mine) {
#pragma unroll
                  for (int e = 0; e < 16; ++e) { p0[e] = NEG; p1[e] = NEG; } }
              softmax_step(p0, p1, m, l, o, wsf, r, h, true); pv(o, p0, p1, lds, r, h); }
      }
      l += __shfl_xor(l, 32); scale_rows(o, g1 / fmaxf(l, 1e-30f), wsf, r, h); stash_add(stash, o, tid); stash_store(stash, o, tid); }
    { const bf16_t* kb = C.U() + (size_t)b * SEQ * NU + U_KW; const bf16_t* vb = C.VTVW() + (size_t)b * 128 * SEQ;
      m = NEG; l = 0.f; zero_o(o); const int jlo = qb > 8 ? qb - 8 : 0;
      prefetch<128>(tid, P, kb + (size_t)jlo * 64 * NU, NU, vb + jlo * 64, SEQ, true);
      for (int j = jlo; j <= qb; ++j) {
          __syncthreads(); commit<128>(tid, P, lds, true); __syncthreads();
          if (j < qb) prefetch<128>(tid, P, kb + (size_t)(j + 1) * 64 * NU, NU, vb + (j + 1) * 64, SEQ, true);
          const int d0 = 64 * j + 4 * h - t;
          f32x16 p0, p1; qk<128>(p0, p1, lds, qf, r, h, slope2, slope2 * (float)d0);
          if (j == qb || j + 8 <= qb) {
#pragma unroll
              for (int e = 0; e < 16; ++e) { const int dk = d0 + (e & 3) + 8 * (e >> 2);
                  if (dk > 0 || dk <= -512) p0[e] = NEG; if (dk + 32 > 0 || dk + 32 <= -512) p1[e] = NEG; } }
          softmax_step(p0, p1, m, l, o, wsf, r, h, true); pv(o, p0, p1, lds, r, h);
      }
      l += __shfl_xor(l, 32); scale_rows(o, g2 / fmaxf(l, 1e-30f), wsf, r, h); stash_add(stash, o, tid); }
    finish_write(o, C.a->in[31] + C.layer * 128, 1.f, C.MIX() + ((size_t)b * SEQ + t0) * DM + 1024 + hd * 128, DM, r, h);
}
DI void attn_phase(LAS unsigned char* lds, const Ctx& C, unsigned* ctr) {
    LAS int* misc = (LAS int*)(lds + OFF_MISC);
    for (;;) {
        __syncthreads();
        if (otid() == 0) misc[0] = (int)__hip_atomic_fetch_add(ctr, 1u, __ATOMIC_RELAXED, __HIP_MEMORY_SCOPE_AGENT);
        __syncthreads();
        const int p = __builtin_amdgcn_readfirstlane(misc[0]);
        if (p >= 1024) break;
        int type, bh, qb;
        if (p < 256) { type = 3; qb = 63 - (p >> 2); bh = p & 3; }
        else { const int pp = p - 256, g = pp / 48, q = pp - 48 * g; qb = 15 - g; type = q >> 4; bh = q & 15; }
#ifndef NO_DIFF
        if (type == 0) { if (diff_fixed_ok(C)) unit_diff<true>(lds, C, bh >> 2, bh & 3, qb); else unit_diff<false>(lds, C, bh >> 2, bh & 3, qb); }
#endif
#ifndef NO_SB
        if (type == 1) unit_sb(lds, C, bh >> 2, bh & 3, qb);
#endif
#ifndef NO_MLA
        if (type == 2) unit_mla(lds, C, bh >> 2, bh & 3, qb);
#endif
#ifndef NO_NSA
        if (type == 3) unit_nsa(lds, C, bh, qb);
#endif
    }
}
}

#ifndef PROBE_SEAM
#define PROBE_SEAM 0
#endif
#ifndef PROBE_SPIN
#define PROBE_SPIN 0
#endif
#ifndef PROBE_DOUBLE
#define PROBE_DOUBLE 0
#endif
#ifndef PHMASK
#define PHMASK 0xffffffffu
#endif
constexpr int LDS_BYTES = 147456;
static_assert(att::LDS_END <= 131072, "attention LDS map");
#define RLX_AGENT __ATOMIC_RELAXED, __HIP_MEMORY_SCOPE_AGENT
#define XB_TMO      128
#define XB_XCNT(j)  (256  + 64 * (j))
#define XB_XSUB(j)  (1280 + 64 * (j))
#define XB_XGEN(j)  (2304 + 64 * (j))
#define XB_TOP      3328
#define XB_TOPGEN   3392
#define XCD_BAR_WORDS 3456
#define XB_SPIN_CAP (1u << 18)

__device__ __forceinline__ unsigned xb_ld(unsigned* p)              { return __hip_atomic_load(p, __ATOMIC_RELAXED, __HIP_MEMORY_SCOPE_AGENT); }
__device__ __forceinline__ unsigned xb_add(unsigned* p, unsigned v) { return __hip_atomic_fetch_add(p, v, __ATOMIC_RELAXED, __HIP_MEMORY_SCOPE_AGENT); }
__device__ __forceinline__ unsigned xb_xcc_id() { return (unsigned)__builtin_amdgcn_s_getreg((3 << 11) | 20) & 0xFu; }
#define XB_SPIN(cond, bar) do { unsigned _sp = 0; while (cond) { __builtin_amdgcn_s_sleep(1); \
    if ((++_sp & 255u) == 0u) { if (xb_ld(&(bar)[XB_TMO])) break; if (_sp > XB_SPIN_CAP) { atomicAdd(&(bar)[XB_TMO], 1u); break; } } } } while (0)

struct XcdBarrier {
    unsigned* bar; unsigned x;
    volatile LAS unsigned* st;
};

__device__ __forceinline__ XcdBarrier xcd_barrier_post(unsigned* bar, volatile LAS unsigned* st) {
    XcdBarrier b; b.bar = bar; b.x = xb_xcc_id(); b.st = st;
    if (threadIdx.x == 0) (void)xb_add(&bar[XB_XCNT(b.x)], 1u);
    return b;
}
__device__ __forceinline__ void xcd_barrier_complete(unsigned* bar, unsigned x, unsigned& nloc, unsigned& nx) {
    const unsigned G = gridDim.x * gridDim.y * gridDim.z;
    unsigned sum, cnt, mine, sp = 0u;
    for (;;) {
        sum = 0u; cnt = 0u; mine = 0u;
#pragma unroll
        for (unsigned j = 0; j < 16; ++j) { const unsigned c = xb_ld(&bar[XB_XCNT(j)]); sum += c; cnt += (c > 0u) ? 1u : 0u; mine = (j == x) ? c : mine; }
        if (sum == G) break;
        __builtin_amdgcn_s_sleep(1);
        if ((++sp & 255u) == 0u) { if (xb_ld(&bar[XB_TMO])) break; if (sp > XB_SPIN_CAP) { atomicAdd(&bar[XB_TMO], 1u); break; } }
    }
    nloc = mine > 0u ? mine : 1u; nx = cnt > 0u ? cnt : 1u;
}

__device__ __forceinline__ void xcd_barrier(const XcdBarrier& b) {
    asm volatile("s_waitcnt vmcnt(0)" ::: "memory");
    __syncthreads();
    if (threadIdx.x == 0) {
        unsigned* bar = b.bar;
        __builtin_amdgcn_s_waitcnt(0);
        unsigned nloc = b.st[0], nx = b.st[1];
        if (nloc == 0u) { xcd_barrier_complete(bar, b.x, nloc, nx); b.st[0] = nloc; b.st[1] = nx; }
        const unsigned old = xb_add(&bar[XB_XSUB(b.x)], 1u);
        const unsigned gen = old / nloc;
        if (old + 1u == (gen + 1u) * nloc) {
            __builtin_amdgcn_fence(__ATOMIC_RELEASE, "agent");
            asm volatile("s_waitcnt vmcnt(0)" ::: "memory");
            const unsigned og = xb_add(&bar[XB_TOP], 1u);
            const unsigned tg = og / nx;
            if (og + 1u == (tg + 1u) * nx) xb_add(&bar[XB_TOPGEN], 1u);
            else XB_SPIN(xb_ld(&bar[XB_TOPGEN]) == tg, bar);
            __builtin_amdgcn_fence(__ATOMIC_ACQUIRE, "agent");
            xb_add(&bar[XB_XGEN(b.x)], 1u);
            asm volatile("s_waitcnt vmcnt(0)" ::: "memory");
        } else {
            XB_SPIN(xb_ld(&bar[XB_XGEN(b.x)]) == gen, bar);
            __builtin_amdgcn_fence(__ATOMIC_ACQUIRE, "agent");
            asm volatile("s_waitcnt vmcnt(0)" ::: "memory");
        }
    }
    __syncthreads();
}

struct GemmDesc { const bf16_t* A; int lda; const void* Bt; int M, N, K; pg8::EpiAny E; int crot; };
DI GemmDesc get_gemm(const Ctx& C, const Args& a, int s, int gi) {
    unsigned char* wl = C.wl(); float* hres = a.out; GemmDesc d; d.crot = 0;
    d.E.mode = 0; d.E.O = nullptr; d.E.ldc = 0; d.E.ncols = 0; d.E.base = nullptr; d.E.out = nullptr; d.E.alpha = 0.f;
    if (s == 0 || s == 10) { d.A = C.XN(); d.lda = DM; d.Bt = wl + (s == 0 ? W_GU1 : W_GU2); d.M = NTOK; d.N = 2 * DFF; d.K = DM; d.E.mode = 1; d.E.O = C.HID(); d.E.ldc = DFF; }
    else if (s == 1 || s == 11) { d.A = C.HID(); d.lda = DFF; d.Bt = wl + (s == 1 ? W_D1 : W_D2); d.M = NTOK; d.N = DM; d.K = DFF; d.E.mode = 2;
        d.E.base = (s == 1 && C.layer == 0) ? a.in[0] : hres; d.E.out = hres; d.E.ldc = DM; d.E.alpha = 0.5f; }
    else if (s == 3) { d.A = C.XN(); d.lda = DM; d.Bt = wl + W_IN; d.M = NTOK; d.N = 5120; d.K = DM; d.E.O = C.U(); d.E.ldc = NU; d.E.ncols = 5120; }
    else if (s == 8) { d.A = C.MIX(); d.lda = DM; d.Bt = wl + W_OUT; d.M = NTOK; d.N = DM; d.K = DM; d.E.mode = 2; d.E.base = hres; d.E.out = hres; d.E.ldc = DM; d.E.alpha = 1.0f; }
    else if (gi == 0) { d.A = C.U() + U_CQ; d.lda = NU; d.Bt = wl + W_UQ; d.M = NTOK; d.N = 768; d.K = 512; d.E.O = C.QM(); d.E.ldc = 768; d.E.ncols = 768; }
    else if (gi == 1) { d.A = C.U() + U_CKV; d.lda = NU; d.Bt = wl + W_UKV; d.M = NTOK; d.N = 1024; d.K = 256; d.E.O = C.KVR(); d.E.ldc = 1024; d.E.ncols = 1024; }
    else if (gi == 2) { d.A = C.AK(); d.lda = 4096; d.Bt = wl + W_CK; d.M = 1024; d.N = 256; d.K = 4096; d.E.O = C.KC(); d.E.ldc = 128; d.E.ncols = 128; d.crot = 192; }
    else if (gi == 4) { d.A = C.XN(); d.lda = DM; d.Bt = (const bf16_t*)(wl + W_IN) + (size_t)5120 * DM; d.M = NTOK; d.N = 256; d.K = DM; d.E.O = C.U() + 5120; d.E.ldc = NU; d.E.ncols = 256; d.crot = 128; }
    else { d.A = C.AV(); d.lda = 4096; d.Bt = wl + W_CV; d.M = 1024; d.N = 256; d.K = 4096; d.E.O = C.VCR(); d.E.ldc = 128; d.E.ncols = 128; d.crot = 200; }
    return d;
}
__global__ void __launch_bounds__(512, 2) mega_fwd(Args a) {
    extern __shared__ __attribute__((aligned(16))) unsigned char lds_raw[];
    LAS unsigned char* lds = (LAS unsigned char*)lds_raw;
    cg::grid_group grid = cg::this_grid();
    const int NSTEP = 13 * NLAYER;
    volatile LAS unsigned* MISC = (volatile LAS unsigned*)(lds + 131072 + 320);
    if (threadIdx.x < 32) MISC[threadIdx.x] = 0u;
    __syncthreads();
#pragma unroll 1
    for (int step = 0; step < NSTEP; ++step) {
#if PROBE_SPIN
        unsigned long long pt0s = __builtin_amdgcn_s_memrealtime();
#endif
        if (step >= a.ph_lo && step < a.ph_hi) {
#if PROBE_SPIN
            const unsigned long long pt0 = __builtin_amdgcn_s_memrealtime();
#endif
            const int tid = otid(), lane = tid & 63, wave = __builtin_amdgcn_readfirstlane(tid >> 6);
            const int G = gridDim.x, c = blockIdx.x, gw = c * 8 + wave, NGW = G * 8;
            if (step == 0) {
                { const XcdBarrier b0 = xcd_barrier_post((unsigned*)(a.ws + WS_CTL) + 1024, MISC + 8); if (threadIdx.x == 0) MISC[10] = b0.x; }
#ifndef NO_P0
                for (int rep = 0; rep < (PROBE_DOUBLE == 3 ? 2 : 1); ++rep) p0_weights(a, lds, gw, NGW, wave, lane);
                norm_rows(a.in[0], (bf16_t*)(a.ws + WS_XN), gw, NGW, lane);
#endif
            }
            else {
                const int L = (step - 1) / 13, s = (step - 1) - 13 * L; const Ctx C = make_ctx(a, L);
                const int ng = (s == 0 || s == 1 || s == 3 || s == 8 || s == 10 || s == 11) ? 1 : (s == 5 ? 5 : 0);
                if (ng) {
#pragma unroll 1
                    for (int gi0 = 0; gi0 < ng * ((PROBE_DOUBLE == 2 && (s == 0 || s == 10)) ? 2 : 1); ++gi0) { const int gi = gi0 % ng; const GemmDesc d = get_gemm(C, a, s, gi);
                        pg8::Gemm g{d.A, (const bf16_t*)d.Bt, d.M, d.N, d.K, d.lda}; pg8::StaticOrder S; S.init(d.M, d.N, G, (c + G - (d.crot % G)) % G);
                        pg8::gemm_phase<pg8::EpiAny, pg8::StaticOrder, true, true>(lds, g, S, d.E); }
                }
#ifndef NO_NORM
                else if (s == 2 || s == 9 || s == 12) norm_rows(a.out, C.XN(), gw, NGW, lane);
#endif
#ifndef NO_FIX
                else if (s == 4) fix1(C, gw, NGW, lane);
                else if (s == 6) fix2(C, gw, NGW, lane);
#endif
                else if (s == 7) { att::attn_phase(lds, C, (unsigned*)(a.ws + WS_CTL) + 64 + 64 * L);
#if PROBE_DOUBLE == 1
                    att::attn_phase(lds, C, (unsigned*)(a.ws + WS_CTL) + 256 + 64 * L);
#endif
                }
            }
        }
#if PROBE_SPIN
        {
            int cls; if (step == 0) cls = 1; else { const int s = (step - 1) % 13; cls = (s == 0 || s == 1 || s == 3 || s == 8 || s == 10 || s == 11) ? 2 : (s == 2 || s == 9 || s == 12) ? 4 : (s == 4 || s == 6) ? 8 : (s == 5) ? 16 : 32; }
            if (cls & PROBE_SPIN) { const unsigned long long pt1 = __builtin_amdgcn_s_memrealtime(); const unsigned long long dt = pt1 - pt0s;
                while (__builtin_amdgcn_s_memrealtime() - pt1 < dt) __builtin_amdgcn_s_sleep(8); }
        }
#endif
        if (step >= a.ph_lo && step + 1 < a.ph_hi && step + 1 < NSTEP) { if (step == 0) grid.sync(); else { XcdBarrier bar; bar.bar = (unsigned*)(a.ws + WS_CTL) + 1024; bar.st = MISC + 8; bar.x = MISC[10]; xcd_barrier(bar);
#if PROBE_SEAM
            xcd_barrier(bar); xcd_barrier(bar);
#endif
            } }
    }
}

extern "C" void kernel_launch(void* const* d_in, const int* in_sizes, int n_in, void* d_out, int out_size, void* d_ws, size_t ws_size, hipStream_t stream) {
    static int grid = 0;
    if (grid == 0) {
        if (n_in != 38 || out_size != NTOK * DM || ws_size < WS_END) { fprintf(stderr, "kernel_launch: unexpected shapes (n_in %d, out %d, ws %zu, need %zu)\n", n_in, out_size, ws_size, (size_t)WS_END); grid = -1; return; }
        int dev = 0, cus = 0, per_cu = 0;
        if (hipGetDevice(&dev) != hipSuccess || hipDeviceGetAttribute(&cus, hipDeviceAttributeMultiprocessorCount, dev) != hipSuccess) { grid = -1; return; }
        if (hipFuncSetAttribute((const void*)mega_fwd, hipFuncAttributeMaxDynamicSharedMemorySize, LDS_BYTES) != hipSuccess) { fprintf(stderr, "kernel_launch: hipFuncSetAttribute failed\n"); grid = -1; return; }
        if (hipOccupancyMaxActiveBlocksPerMultiprocessor(&per_cu, (const void*)mega_fwd, 512, LDS_BYTES) != hipSuccess || per_cu < 1) { fprintf(stderr, "kernel_launch: occupancy query says %d\n", per_cu); (void)hipGetLastError(); }
        grid = cus;
    }
    if (grid < 0) return;
    (void)hipMemsetAsync((char*)d_ws + WS_CTL, 0, 32768, stream);
    Args a{};
    for (int i = 0; i < 38; ++i) a.in[i] = (const float*)d_in[i];
    a.out = (float*)d_out; a.ws = (unsigned char*)d_ws;
    for (int i = 0; i < 32; ++i) a.inv_freq[i] = (float)pow(10000.0, -(double)(2 * i) / 64.0);
    a.ph_lo = 0; a.ph_hi = 1 << 20;
    void* args[] = {&a};
    hipError_t e = hipLaunchCooperativeKernel((const void*)mega_fwd, dim3(grid), dim3(512), args, LDS_BYTES, stream);
    if (e != hipSuccess) fprintf(stderr, "kernel_launch: cooperative launch failed: %s (grid %d)\n", hipGetErrorString(e), grid);
}
```

```cpp
#include <hip/hip_runtime.h>
#include <hip/hip_cooperative_groups.h>
#include <cstdio>
#include <cstdint>
#include <cmath>
namespace cg = cooperative_groups;
namespace pg8 {
#define PG8_LAS __attribute__((address_space(3)))
typedef unsigned short bf16_t;
typedef short bf16x8 __attribute__((ext_vector_type(8)));
typedef float f32x4 __attribute__((ext_vector_type(4)));
typedef unsigned u32x4 __attribute__((ext_vector_type(4)));
constexpr int BM = 256, BK = 64, HALF = 128, HTB = HALF * BK * 2  , STAGE_BYTES = 8 * HTB, NXCD = 8, WGM = 8;

__host__ __device__ __forceinline__ int lds_byte(int r, int c) { const int st = (r >> 4) * 2 + (c >> 5), rr = r & 15, cc = c & 31, ob = rr * 64 + cc * 2; return st * 1024 + (ob ^ (((ob >> 9) & 1) << 5)); }
__host__ __device__ __forceinline__ void stage_rc(int b, int& R, int& C) { const int st = b / 1024, sb = b % 1024, swz = sb ^ (((sb >> 9) & 1) << 5); R = (st >> 1) * 16 + swz / 64; C = (st & 1) * 32 + (swz % 64) / 2; }
__host__ __device__ __forceinline__ int perm32(int rho) { const int n = rho >> 4, i = rho & 15; return 8 * (i >> 2) + 4 * n + (i & 3); }

struct Unit { int pm, pn; };
struct Gemm { const bf16_t* A; const bf16_t* Bt; int M, N, K, lda; };

struct StaticOrder {
    int nM, nN, nwg, G, c;
    __host__ __device__ void init(int M, int N, int G_, int c_) { nM = M / BM; nN = N / BM; nwg = nM * nN; G = G_; c = c_; }
    __host__ __device__ bool next(int i, Unit& u) const {
        const long L = (long)i * G + c; if (L >= nwg) return false;
        int wgid = (int)L; { const int q = nwg / NXCD, r = nwg % NXCD, xcd = wgid % NXCD, off = wgid / NXCD; wgid = (xcd < r ? xcd * (q + 1) : r * (q + 1) + (xcd - r) * q) + off; }
        const int nig = WGM * nN, gid = wgid / nig, fm = gid * WGM, gsz = (nM - fm) < WGM ? (nM - fm) : WGM;
        u.pm = fm + ((wgid % nig) % gsz); u.pn = (wgid % nig) / gsz; return true;
    }
    __device__ __forceinline__ void a_ready(const Unit&) const {}
    __device__ __forceinline__ void done(const Unit&) const {}
};

__device__ __forceinline__ unsigned cvt_pk_bf16(float lo, float hi) { unsigned r; asm volatile("v_cvt_pk_bf16_f32 %0, %1, %2" : "=v"(r) : "v"(lo), "v"(hi)); return r; }
typedef float f32x2 __attribute__((ext_vector_type(2)));
struct EpiStoreBf16 {
    static constexpr bool PERM = true, AFTER_DRAIN = false;
    bf16_t* O; int ldc; int ncols;
    __device__ __forceinline__ void operator()(const f32x4 (&acc)[2][2][4][2], const Unit& u, int wr, int wc, int fr, int fq) const {
        const int row0 = u.pm * BM + wr * 64 + fr; const int col0 = u.pn * BM + wc * 32 + 8 * fq;
#pragma unroll
        for (int ai = 0; ai < 2; ++ai)
#pragma unroll
            for (int m = 0; m < 4; ++m) { bf16_t* rowp = O + (size_t)(row0 + ai * HALF + m * 16) * ldc;
#pragma unroll
                for (int bj = 0; bj < 2; ++bj) { const int c = col0 + bj * HALF;
                    if (c < ncols) { const f32x4 v0 = acc[ai][bj][m][0], v1 = acc[ai][bj][m][1]; u32x4 w;
                        w.x = cvt_pk_bf16(v0[0], v0[1]); w.y = cvt_pk_bf16(v0[2], v0[3]); w.z = cvt_pk_bf16(v1[0], v1[1]); w.w = cvt_pk_bf16(v1[2], v1[3]);
                        *(u32x4*)(rowp + c) = w; } } }
    }
};
struct EpiSwiGLU {
    static constexpr bool PERM = true, AFTER_DRAIN = false;
    bf16_t* H; int ldc;
    __device__ __forceinline__ void operator()(const f32x4 (&acc)[2][2][4][2], const Unit& u, int wr, int wc, int fr, int fq) const {
        const int row0 = u.pm * BM + wr * 64 + fr; const int col0 = u.pn * HALF + wc * 32 + 8 * fq;
#pragma unroll
        for (int ai = 0; ai < 2; ++ai)
#pragma unroll
            for (int m = 0; m < 4; ++m) { bf16_t* rowp = H + (size_t)(row0 + ai * HALF + m * 16) * ldc + col0;
                float r[8];
#pragma unroll
                for (int n = 0; n < 2; ++n)
#pragma unroll
                    for (int e = 0; e < 4; ++e) { const float g = acc[ai][0][m][n][e], up = acc[ai][1][m][n][e];
                        r[n * 4 + e] = g * up * __builtin_amdgcn_rcpf(1.0f + __builtin_amdgcn_exp2f(g)); }
                u32x4 w; w.x = cvt_pk_bf16(r[0], r[1]); w.y = cvt_pk_bf16(r[2], r[3]); w.z = cvt_pk_bf16(r[4], r[5]); w.w = cvt_pk_bf16(r[6], r[7]);
                *(u32x4*)rowp = w; }
    }
};
struct EpiResid {
    static constexpr bool PERM = false, AFTER_DRAIN = false;
    const float* base; float* out; int ldc; float alpha;
    __device__ __forceinline__ void operator()(const f32x4 (&acc)[2][2][4][2], const Unit& u, int wr, int wc, int fr, int fq) const {
        const int row0 = u.pm * BM + wr * 64 + fr; const int col0 = u.pn * BM + wc * 32 + 4 * fq;
#pragma unroll
        for (int ai = 0; ai < 2; ++ai) {
            f32x4 b[4][2][2];
#pragma unroll
            for (int m = 0; m < 4; ++m) { const size_t off = (size_t)(row0 + ai * HALF + m * 16) * ldc + col0;
#pragma unroll
                for (int bj = 0; bj < 2; ++bj)
#pragma unroll
                    for (int n = 0; n < 2; ++n) b[m][bj][n] = *(const f32x4*)(base + off + bj * HALF + n * 16); }
#pragma unroll
            for (int m = 0; m < 4; ++m) { const size_t off = (size_t)(row0 + ai * HALF + m * 16) * ldc + col0;
#pragma unroll
                for (int bj = 0; bj < 2; ++bj)
#pragma unroll
                    for (int n = 0; n < 2; ++n) *(f32x4*)(out + off + bj * HALF + n * 16) = b[m][bj][n] + acc[ai][bj][m][n] * alpha; }
            asm volatile("" ::: "memory");
        }
    }
};
struct EpiAny {
    static constexpr bool AFTER_DRAIN = false;
    int mode; bf16_t* O; int ldc; int ncols; const float* base; float* out; float alpha;
    __device__ __forceinline__ bool perm() const { return mode != 2; }
    __device__ __forceinline__ void operator()(const f32x4 (&acc)[2][2][4][2], const Unit& u, int wr, int wc, int fr, int fq) const {
#ifndef NO_E0
        if (mode == 0) { EpiStoreBf16 e{O, ldc, ncols}; e(acc, u, wr, wc, fr, fq); }
#endif
#ifndef NO_E1
        if (mode == 1) { EpiSwiGLU e{O, ldc}; e(acc, u, wr, wc, fr, fq); }
#endif
#ifndef NO_E2
        if (mode == 2) { EpiResid e{base, out, ldc, alpha}; e(acc, u, wr, wc, fr, fq); }
#endif
    }
};
template <class Epi, class Sched, bool ALIGN_EPI = false, bool SP2 = false>
__device__ __forceinline__ void gemm_phase(PG8_LAS unsigned char* lds, const Gemm g, const Sched& S, const Epi& E) {
    int tid = threadIdx.x; asm volatile("" : "+v"(tid)); const int wid = __builtin_amdgcn_readfirstlane(tid >> 6), lane = tid & 63, wr = wid >> 2, wc = wid & 3, fr = lane & 15, fq = lane >> 4;
    const int K = g.K, nt = K / BK;
    unsigned voffA[2], voffB[2];
#pragma unroll
    for (int i = 0; i < 2; ++i) { int R, C; stage_rc(tid * 16 + i * 8192, R, C); const int Rb = E.perm() ? ((R & ~31) + perm32(R & 31)) : R;
        voffA[i] = (unsigned)(R * g.lda + C) * 2u; voffB[i] = (unsigned)(Rb * K + C) * 2u; }
    const size_t kstep = (size_t)(BK * 2);
    const size_t hstep = (size_t)HALF * K * 2;
    const size_t tstep = 2 * hstep; const size_t hstepA = (size_t)HALF * g.lda * 2, tstepA = 2 * hstepA;
    const unsigned ldsw = (unsigned)wid * 1024u;
    const int aoff = lds_byte(wr * 64 + fr, fq * 8), boff = lds_byte(wc * 32 + fr, fq * 8);
#define PG8_SA(b, h) (((b) * 2 + (h)) * HTB)
#define PG8_SB(b, h) ((4 + (b) * 2 + (h)) * HTB)
#define PG8_STAGE(bufoff, gbase, voff) do { _Pragma("unroll") for (int _i = 0; _i < 2; ++_i) \
        __builtin_amdgcn_global_load_lds((const unsigned*)((const char*)(gbase) + (voff)[_i]), (PG8_LAS unsigned*)(lds + (bufoff) + ldsw + _i * 8192), 16, 0, 0); } while (0)
#define PG8_LDA(dst, b, h) do { _Pragma("unroll") for (int m = 0; m < 4; ++m) _Pragma("unroll") for (int k = 0; k < 2; ++k) dst[m][k] = *(const PG8_LAS bf16x8*)(lds + PG8_SA(b, h) + aoff + m * 2048 + k * 1024); } while (0)
#define PG8_LDB(dst, b, h) do { _Pragma("unroll") for (int n = 0; n < 2; ++n) _Pragma("unroll") for (int k = 0; k < 2; ++k) dst[n][k] = *(const PG8_LAS bf16x8*)(lds + PG8_SB(b, h) + boff + n * 2048 + k * 1024); } while (0)
#define PG8_MMA(ai, bj, At, Bt) do { __builtin_amdgcn_s_setprio(1); _Pragma("unroll") for (int m = 0; m < 4; ++m) _Pragma("unroll") for (int n = 0; n < 2; ++n) _Pragma("unroll") for (int k = 0; k < 2; ++k) \
        acc[ai][bj][m][n] = __builtin_amdgcn_mfma_f32_16x16x32_bf16(Bt[n][k], At[m][k], acc[ai][bj][m][n], 0, 0, 0); __builtin_amdgcn_s_setprio(0); } while (0)
#define PG8_WAIT_V(n) asm volatile("s_waitcnt vmcnt(" #n ")" ::: "memory")
#define PG8_WAIT_L(n) asm volatile("s_waitcnt lgkmcnt(" #n ")" ::: "memory")
#define PG8_BAR __builtin_amdgcn_s_barrier()
#define PG8_SCHED __builtin_amdgcn_sched_barrier(0)
    Unit cur, nxt; int ui = 0;
    if (!S.next(0, cur)) return;
    f32x4 acc[2][2][4][2];
#pragma unroll
    for (int a = 0; a < 2; ++a)
#pragma unroll
        for (int b = 0; b < 2; ++b)
#pragma unroll
            for (int m = 0; m < 4; ++m)
#pragma unroll
                for (int n = 0; n < 2; ++n) acc[a][b][m][n] = (f32x4){0.f, 0.f, 0.f, 0.f};
    bf16x8 At[4][2], B0[2][2], B1[2][2];
    const char* cA = (const char*)g.A + (size_t)cur.pm * tstepA; const char* cB = (const char*)g.Bt + (size_t)cur.pn * tstep;
    S.a_ready(cur);
    if constexpr (SP2) {
        PG8_STAGE(PG8_SB(0, 0), cB, voffB); PG8_STAGE(PG8_SB(0, 1), cB + hstep, voffB); PG8_STAGE(PG8_SA(0, 0), cA, voffA); PG8_STAGE(PG8_SA(0, 1), cA + hstepA, voffA);
        if (wr == 1) PG8_BAR;
        PG8_WAIT_V(2); PG8_BAR;
        PG8_STAGE(PG8_SB(1, 0), cB + kstep, voffB); PG8_STAGE(PG8_SA(1, 0), cA + kstep, voffA); PG8_STAGE(PG8_SB(1, 1), cB + hstep + kstep, voffB);
        PG8_WAIT_V(6); PG8_BAR;
    } else {
        PG8_STAGE(PG8_SB(0, 0), cB, voffB); PG8_STAGE(PG8_SA(0, 0), cA, voffA); PG8_STAGE(PG8_SB(0, 1), cB + hstep, voffB); PG8_STAGE(PG8_SA(0, 1), cA + hstepA, voffA);
        if (wr == 1) PG8_BAR;
        PG8_WAIT_V(4); PG8_BAR;
        PG8_STAGE(PG8_SB(1, 0), cB + kstep, voffB); PG8_STAGE(PG8_SA(1, 0), cA + kstep, voffA); PG8_STAGE(PG8_SB(1, 1), cB + hstep + kstep, voffB);
        PG8_WAIT_V(6); PG8_BAR;
    }
    for (;;) {
        const bool has_next = S.next(ui + 1, nxt);
        const char* nA = has_next ? (const char*)g.A + (size_t)nxt.pm * tstepA : cA; const char* nB = has_next ? (const char*)g.Bt + (size_t)nxt.pn * tstep : cB;
        for (int t = 0; t < nt; t += 2) {
            const bool last = (t == nt - 2);
            const char* a1 = cA + (size_t)(t + 1) * kstep;
            const char* a2 = last ? nA : cA + (size_t)(t + 2) * kstep; const char* b2 = last ? nB : cB + (size_t)(t + 2) * kstep;
            const char* a3 = a2 + kstep; const char* b3 = b2 + kstep;
            if (last && has_next) S.a_ready(nxt);
            if constexpr (SP2) {
            PG8_LDB(B0, 0, 0); PG8_LDB(B1, 0, 1); PG8_SCHED; PG8_LDA(At, 0, 0); PG8_STAGE(PG8_SA(1, 1), a1 + hstepA, voffA);
            PG8_WAIT_V(8); PG8_WAIT_L(0); PG8_BAR; PG8_MMA(0, 0, At, B0); PG8_MMA(0, 1, At, B1); PG8_BAR; PG8_SCHED;
            PG8_LDA(At, 0, 1); PG8_STAGE(PG8_SB(0, 0), b2, voffB); PG8_STAGE(PG8_SB(0, 1), b2 + hstep, voffB); PG8_STAGE(PG8_SA(0, 0), a2, voffA);
            PG8_WAIT_V(8); PG8_WAIT_L(0); PG8_BAR; PG8_MMA(1, 0, At, B0); PG8_MMA(1, 1, At, B1); PG8_BAR; PG8_SCHED;
            PG8_LDB(B0, 1, 0); PG8_LDB(B1, 1, 1); PG8_SCHED; PG8_LDA(At, 1, 0); PG8_STAGE(PG8_SA(0, 1), a2 + hstepA, voffA);
            PG8_WAIT_V(8); PG8_WAIT_L(0); PG8_BAR; PG8_MMA(0, 0, At, B0); PG8_MMA(0, 1, At, B1); PG8_BAR; PG8_SCHED;
            PG8_LDA(At, 1, 1); PG8_STAGE(PG8_SB(1, 0), b3, voffB); PG8_STAGE(PG8_SB(1, 1), b3 + hstep, voffB); PG8_STAGE(PG8_SA(1, 0), a3, voffA);
            PG8_WAIT_V(8); PG8_WAIT_L(0); PG8_BAR; PG8_MMA(1, 0, At, B0); PG8_MMA(1, 1, At, B1); PG8_BAR; PG8_SCHED;
            } else {
            PG8_LDB(B0, 0, 0); PG8_SCHED; PG8_LDA(At, 0, 0); PG8_STAGE(PG8_SA(1, 1), a1 + hstepA, voffA);
            PG8_WAIT_L(8); PG8_BAR; PG8_WAIT_L(0); PG8_MMA(0, 0, At, B0); PG8_BAR; PG8_SCHED;
            PG8_LDB(B1, 0, 1); PG8_STAGE(PG8_SB(0, 0), b2, voffB);
            PG8_BAR; PG8_WAIT_L(0); PG8_MMA(0, 1, At, B1); PG8_BAR;
            PG8_LDA(At, 0, 1); PG8_STAGE(PG8_SA(0, 0), a2, voffA);
            PG8_BAR; PG8_WAIT_L(0); PG8_MMA(1, 0, At, B0); PG8_BAR; PG8_SCHED;
            PG8_STAGE(PG8_SB(0, 1), b2 + hstep, voffB);
            PG8_WAIT_V(6); PG8_BAR; PG8_MMA(1, 1, At, B1); PG8_BAR;
            PG8_LDB(B0, 1, 0); PG8_SCHED; PG8_LDA(At, 1, 0); PG8_STAGE(PG8_SA(0, 1), a2 + hstepA, voffA);
            PG8_WAIT_L(8); PG8_BAR; PG8_WAIT_L(0); PG8_MMA(0, 0, At, B0); PG8_BAR; PG8_SCHED;
            PG8_LDB(B1, 1, 1); PG8_STAGE(PG8_SB(1, 0), b3, voffB);
            PG8_BAR; PG8_WAIT_L(0); PG8_MMA(0, 1, At, B1); PG8_BAR;
            PG8_LDA(At, 1, 1); PG8_STAGE(PG8_SA(1, 0), a3, voffA);
            PG8_BAR; PG8_WAIT_L(0); PG8_MMA(1, 0, At, B0); PG8_BAR; PG8_SCHED;
            PG8_STAGE(PG8_SB(1, 1), b3 + hstep, voffB);
            PG8_WAIT_V(6); PG8_BAR; PG8_MMA(1, 1, At, B1); PG8_BAR;
            }
        }
        if constexpr (ALIGN_EPI) { if (wr == 0) PG8_BAR; }
        if constexpr (!Epi::AFTER_DRAIN) { E(acc, cur, wr, wc, fr, fq); S.done(cur); }
        if (!has_next) break;
#pragma unroll
        for (int a = 0; a < 2; ++a)
#pragma unroll
            for (int b = 0; b < 2; ++b)
#pragma unroll
                for (int m = 0; m < 4; ++m)
#pragma unroll
                    for (int n = 0; n < 2; ++n) acc[a][b][m][n] = (f32x4){0.f, 0.f, 0.f, 0.f};
        cur = nxt; cA = nA; cB = nB; ++ui;
        if constexpr (ALIGN_EPI) { if (wr == 1) PG8_BAR; }
    }
    PG8_WAIT_V(0);
    if constexpr (!ALIGN_EPI) { if (wr == 0) PG8_BAR; }
    PG8_BAR;
    if constexpr (Epi::AFTER_DRAIN) { E.fused(acc, cur, wr, wc, fr, fq, lds, wid, lane); S.done(cur); }
#undef PG8_SA
#undef PG8_SB
#undef PG8_STAGE
#undef PG8_LDA
#undef PG8_LDB
#undef PG8_MMA
#undef PG8_WAIT_V
#undef PG8_WAIT_L
#undef PG8_BAR
#undef PG8_SCHED
}
}

#define DI __device__ __forceinline__
#define LAS __attribute__((address_space(3)))
typedef unsigned short bf16_t;
typedef short bf16x8 __attribute__((ext_vector_type(8)));
typedef short s16x4 __attribute__((ext_vector_type(4)));
typedef float f32x4 __attribute__((ext_vector_type(4)));
typedef float f32x16 __attribute__((ext_vector_type(16)));
typedef unsigned u32x4 __attribute__((ext_vector_type(4)));
typedef unsigned u32x2 __attribute__((ext_vector_type(2)));

constexpr int NTOK = 16384, SEQ = 4096, DM = 2048, DFF = 5632, NU = 5376  , NLAYER = 2;
constexpr float EPS = 1e-6f, LOG2E = 1.4426950408889634f;
constexpr int U_CQ = 0, U_CKV = 512, U_KR = 768, U_DQ = 832, U_DK = 1344, U_DV = 1856, U_NQ = 2368, U_KC = 2880, U_VC = 3008, U_KS = 3136, U_VS = 3264,
              U_KW = 3392, U_VW = 3520, U_SQ = 3648, U_SK = 4160, U_SV = 4672, U_G = 5184;
constexpr size_t MiB = 1u << 20;
constexpr size_t W_GU1 = 0, W_D1 = 44 * MiB, W_IN = 66 * MiB, W_UQ = 87 * MiB, W_UKV = 88 * MiB, W_CK = 89 * MiB, W_CV = 90 * MiB, W_OUT = 92 * MiB, W_GU2 = 100 * MiB,
                 W_D2 = 144 * MiB, W_LAYER = 166 * MiB;
constexpr size_t WS_CTL = 0, WS_W = 1 * MiB, WS_XN = WS_W + 2 * W_LAYER  , WS_HID = WS_XN + 64 * MiB  ,
                 WS_QM = WS_HID + 176 * MiB  , WS_KM = WS_QM + 24 * MiB, WS_KVR = WS_KM + 24 * MiB, WS_VTM = WS_KVR + 32 * MiB, WS_VTD = WS_VTM + 16 * MiB,
                 WS_VTS = WS_VTD + 16 * MiB, WS_VTVS = WS_VTS + 16 * MiB, WS_VTVW = WS_VTVS + 4 * MiB, WS_AK = WS_VTVW + 4 * MiB, WS_AV = WS_AK + 8 * MiB,
                 WS_KC = WS_AV + 9 * MiB, WS_VCR = WS_KC + 1 * MiB, WS_VTVC = WS_VCR + 1 * MiB, WS_STASH = WS_VTVC + 1 * MiB  , WS_END = WS_STASH + 32 * MiB;
static_assert(WS_END <= 762 * MiB, "workspace map");

DI float bf2f(unsigned b) { return __uint_as_float(b << 16); }
typedef float f32x2_t __attribute__((ext_vector_type(2))); typedef __bf16 bf16x2_t __attribute__((ext_vector_type(2)));
DI unsigned pk2(float lo, float hi) { f32x2_t v = {lo, hi}; bf16x2_t b = __builtin_convertvector(v, bf16x2_t); return __builtin_bit_cast(unsigned, b); }
DI float wave_sum(float v) {
#pragma unroll
    for (int o = 1; o < 64; o <<= 1) v += __shfl_xor(v, o);
    return v; }
template <int W> DI float grp_sum(float v) {
#pragma unroll
    for (int o = 1; o < W; o <<= 1) v += __shfl_xor(v, o);
    return v; }
DI void ld8(const bf16_t* p, float (&f)[8]) { const u32x4 v = *(const u32x4*)p;
    f[0] = bf2f(v.x & 0xffffu); f[1] = bf2f(v.x >> 16); f[2] = bf2f(v.y & 0xffffu); f[3] = bf2f(v.y >> 16);
    f[4] = bf2f(v.z & 0xffffu); f[5] = bf2f(v.z >> 16); f[6] = bf2f(v.w & 0xffffu); f[7] = bf2f(v.w >> 16); }
DI void st8(bf16_t* p, const float (&f)[8]) { u32x4 w; w.x = pk2(f[0], f[1]); w.y = pk2(f[2], f[3]); w.z = pk2(f[4], f[5]); w.w = pk2(f[6], f[7]); *(u32x4*)p = w; }
DI float ssq8(const float (&f)[8]) { float s = 0.f;
#pragma unroll
    for (int e = 0; e < 8; ++e) s += f[e] * f[e];
    return s; }
DI int otid() { int t = (int)threadIdx.x; asm volatile("" : "+v"(t)); return t; }
#define LDS_WAIT() asm volatile("s_waitcnt lgkmcnt(0)" ::: "memory")

struct Args { const float* in[38]; float* out; unsigned char* ws; float inv_freq[32]; int ph_lo, ph_hi; };

struct Ctx {
    int layer; const Args* a; unsigned char* ws;
    DI unsigned char* wl() const { return ws + WS_W + (size_t)layer * W_LAYER; }
#define CTX_PTR(name, off) DI bf16_t* name() const { return (bf16_t*)(ws + (off)); }
    CTX_PTR(XN, WS_XN) CTX_PTR(MIX, WS_XN) CTX_PTR(HID, WS_HID) CTX_PTR(U, WS_HID) CTX_PTR(QM, WS_QM) CTX_PTR(KM, WS_KM) CTX_PTR(KVR, WS_KVR) CTX_PTR(VTM, WS_VTM)
    CTX_PTR(VTD, WS_VTD) CTX_PTR(VTS, WS_VTS) CTX_PTR(VTVS, WS_VTVS) CTX_PTR(VTVW, WS_VTVW) CTX_PTR(AK, WS_AK) CTX_PTR(AV, WS_AV) CTX_PTR(KC, WS_KC) CTX_PTR(VCR, WS_VCR)
    CTX_PTR(VTVC, WS_VTVC)
#undef CTX_PTR
};
DI Ctx make_ctx(const Args& a, int layer) { Ctx c; c.layer = layer; c.a = &a; c.ws = a.ws; return c; }

struct WDesc { const float* W; const float* gain; bf16_t* WT; int K, N, mode; float cscale; };
DI int wt_out_row(int mode, int c) {
    if (mode == 1) return 256 * (c >> 7) + (c & 127);
    if (mode == 2) return 256 * (c >> 7) + 128 + (c & 127);
    if (mode == 3) return c < 3648 ? c : (c < 3660 ? U_G + (c - 3648) : c - 12);
    return c;
}
DI void wt_item(const WDesc& d, LAS unsigned* scr, int item, int lane) {
    const int nblk = (d.N + 63) >> 6, kb = item / nblk, nb = item - kb * nblk, k0 = 64 * kb, n0 = 64 * nb;
    const int c = n0 + lane; const bool cv = c < d.N;
    float cs = 1.f; if (d.mode == 3 && c >= 3660 && c < 4172) cs = d.cscale; if (d.mode == 1 || d.mode == 2) cs = d.cscale;
    float wv[64];
    const float* wp = d.W + (size_t)k0 * d.N + (cv ? c : 0);
#pragma unroll
    for (int i = 0; i < 64; ++i) wv[i] = wp[(size_t)i * d.N];
#pragma unroll
    for (int jp = 0; jp < 32; ++jp) { float w0 = cv ? wv[2 * jp] : 0.f, w1 = cv ? wv[2 * jp + 1] : 0.f;
        if (d.gain) { w0 *= d.gain[k0 + 2 * jp]; w1 *= d.gain[k0 + 2 * jp + 1]; }
        scr[jp * 65 + lane] = pk2(w0 * cs, w1 * cs); }
    LDS_WAIT();
    const int ch = lane & 7, nl = lane >> 3;
#pragma unroll
    for (int jn = 0; jn < 8; ++jn) { const int n = nl + 8 * jn; const int cc = n0 + n;
        if (cc < d.N) { const LAS unsigned* sp = scr + (4 * ch) * 65 + n; u32x4 o; o.x = sp[0]; o.y = sp[65]; o.z = sp[130]; o.w = sp[195];
            *(u32x4*)(d.WT + (size_t)wt_out_row(d.mode, cc) * d.K + k0 + 8 * ch) = o; } }
    LDS_WAIT();
}
constexpr int WI_G = 32 * 88, WI_D = 88 * 32, WI_IN = 32 * 82, WI_UQ = 8 * 12, WI_UKV = 4 * 16, WI_C = 64 * 2, WI_OUT = 32 * 32;
constexpr int WI_LAYER = 6 * WI_G + WI_IN + WI_UQ + WI_UKV + 2 * WI_C + WI_OUT;
DI void p0_weights(const Args& a, LAS unsigned char* lds, int gw, int NGW, int wave, int lane) {
    LAS unsigned* scr = (LAS unsigned*)(lds + wave * 8704);
    for (int it = gw; it < NLAYER * WI_LAYER; it += NGW) {
        const int L = it / WI_LAYER; int r = it - L * WI_LAYER; unsigned char* wl = a.ws + WS_W + (size_t)L * W_LAYER;
        const size_t oDF = (size_t)L * DM * DFF, oD = (size_t)L * DM; WDesc d; d.cscale = 1.f; d.gain = nullptr;
        if (r < WI_G) { d = WDesc{a.in[2] + oDF, a.in[1] + oD, (bf16_t*)(wl + W_GU1), DM, DFF, 1, -LOG2E}; }
        else if ((r -= WI_G) < WI_G) { d = WDesc{a.in[3] + oDF, a.in[1] + oD, (bf16_t*)(wl + W_GU1), DM, DFF, 2, -1.0f / LOG2E}; }
        else if ((r -= WI_G) < WI_D) { d = WDesc{a.in[4] + oDF, nullptr, (bf16_t*)(wl + W_D1), DFF, DM, 0, 1.f}; }
        else if ((r -= WI_D) < WI_IN) { d = WDesc{a.in[6] + (size_t)L * DM * 5196, a.in[5] + oD, (bf16_t*)(wl + W_IN), DM, 5196, 3, 0.08838834764831845f * LOG2E}; }
        else if ((r -= WI_IN) < WI_UQ) { d = WDesc{a.in[9] + (size_t)L * 512 * 768, a.in[7] + (size_t)L * 512, (bf16_t*)(wl + W_UQ), 512, 768, 0, 1.f}; }
        else if ((r -= WI_UQ) < WI_UKV) { d = WDesc{a.in[10] + (size_t)L * 256 * 1024, a.in[8] + (size_t)L * 256, (bf16_t*)(wl + W_UKV), 256, 1024, 0, 1.f}; }
        else if ((r -= WI_UKV) < WI_C) { d = WDesc{a.in[25] + (size_t)L * 4096 * 128, nullptr, (bf16_t*)(wl + W_CK), 4096, 128, 0, 1.f}; }
        else if ((r -= WI_C) < WI_C) { d = WDesc{a.in[27] + (size_t)L * 4096 * 128, nullptr, (bf16_t*)(wl + W_CV), 4096, 128, 0, 1.f}; }
        else if ((r -= WI_C) < WI_OUT) { d = WDesc{a.in[33] + (size_t)L * DM * DM, nullptr, (bf16_t*)(wl + W_OUT), DM, DM, 0, 1.f}; }
        else if ((r -= WI_OUT) < WI_G) { d = WDesc{a.in[35] + oDF, a.in[34] + oD, (bf16_t*)(wl + W_GU2), DM, DFF, 1, -LOG2E}; }
        else if ((r -= WI_G) < WI_G) { d = WDesc{a.in[36] + oDF, a.in[34] + oD, (bf16_t*)(wl + W_GU2), DM, DFF, 2, -1.0f / LOG2E}; }
        else { r -= WI_G; d = WDesc{a.in[37] + oDF, nullptr, (bf16_t*)(wl + W_D2), DFF, DM, 0, 1.f}; }
        wt_item(d, scr, r, lane);
    }
}
DI void norm_rows(const float* src, bf16_t* xn, int gw, int NGW, int lane) {
    for (int m = gw; m < NTOK; m += NGW) {
        const f32x4* xr = (const f32x4*)(src + (size_t)m * DM) + lane; f32x4 v[8]; float s = 0.f;
#pragma unroll
        for (int j = 0; j < 8; ++j) { v[j] = xr[64 * j]; s += (v[j].x * v[j].x + v[j].y * v[j].y) + (v[j].z * v[j].z + v[j].w * v[j].w); }
        const float rstd = 1.0f / sqrtf(wave_sum(s) * (1.0f / DM) + EPS);
        u32x2* o = (u32x2*)(xn + (size_t)m * DM) + lane;
#pragma unroll
        for (int j = 0; j < 8; ++j) { u32x2 w; w.x = pk2(v[j].x * rstd, v[j].y * rstd); w.y = pk2(v[j].z * rstd, v[j].w * rstd); o[64 * j] = w; }
    }
}
DI void up8(const u32x4 v, float (&f)[8]) {
    f[0] = bf2f(v.x & 0xffffu); f[1] = bf2f(v.x >> 16); f[2] = bf2f(v.y & 0xffffu); f[3] = bf2f(v.y >> 16);
    f[4] = bf2f(v.z & 0xffffu); f[5] = bf2f(v.z >> 16); f[6] = bf2f(v.w & 0xffffu); f[7] = bf2f(v.w >> 16); }
DI void rope_cs(float ang, float& c, float& s) { const double rev = (double)ang * 0.15915494309189535; const float fr = (float)(rev - __builtin_rint(rev));
    s = __builtin_amdgcn_sinf(fr); c = __builtin_amdgcn_cosf(fr); }
DI void transpose64(const bf16_t* src_row, bf16_t* dst_lane, size_t dpitch) {
#pragma unroll
    for (int i = 0; i < 8; ++i) { const u32x4 v = *(const u32x4*)(src_row + 8 * i); bf16_t* d = dst_lane + (size_t)(8 * i) * dpitch;
        d[0] = (bf16_t)(v.x & 0xffffu); d[dpitch] = (bf16_t)(v.x >> 16); d[2 * dpitch] = (bf16_t)(v.y & 0xffffu); d[3 * dpitch] = (bf16_t)(v.y >> 16);
        d[4 * dpitch] = (bf16_t)(v.z & 0xffffu); d[5 * dpitch] = (bf16_t)(v.z >> 16); d[6 * dpitch] = (bf16_t)(v.w & 0xffffu); d[7 * dpitch] = (bf16_t)(v.w >> 16); }
}
DI void fix1(const Ctx& C, int gw, int NGW, int lane) {
    const Args& a = *C.a; const int L = C.layer;
    const float* kr_g = a.in[14] + L * 64; const float* dq_g = a.in[16] + L * 64; const float* dk_g = a.in[17] + L * 64; const float* nq_g = a.in[23] + L * 128;
    const float* pe_k = a.in[24] + L * 4096; const float* pe_v = a.in[26] + L * 4096; const float* ks_g = a.in[29] + L * 128; const float* kw_g = a.in[30] + L * 128;
    for (int m = gw; m < NTOK; m += NGW) {
        bf16_t* ur = C.U() + (size_t)m * NU; const int b = m >> 12, s = m & 4095; float f[8];
        const int off_kv = lane < 32 ? U_CKV + 8 * lane : U_KR + 8 * (lane & 7);
        const int off_ms = ((lane >> 4) == 0 ? U_KC : (lane >> 4) == 1 ? U_VC : (lane >> 4) == 2 ? U_KS : U_KW) + 8 * (lane & 15);
        const u32x4 r_cq = *(const u32x4*)(ur + U_CQ + 8 * lane), r_kv = *(const u32x4*)(ur + off_kv), r_dq = *(const u32x4*)(ur + U_DQ + 8 * lane),
                    r_dk = *(const u32x4*)(ur + U_DK + 8 * lane), r_nq = *(const u32x4*)(ur + U_NQ + 8 * lane), r_ms = *(const u32x4*)(ur + off_ms);
        { up8(r_cq, f); const float rstd = 1.0f / sqrtf(wave_sum(ssq8(f)) * (1.0f / 512) + EPS);
#pragma unroll
          for (int e = 0; e < 8; ++e) f[e] *= rstd;
          st8(ur + U_CQ + 8 * lane, f); }
        { const int off = off_kv; up8(r_kv, f); const float q = ssq8(f);
          const float tot = wave_sum(lane < 32 ? q : 0.f); const float kq = grp_sum<8>(q);
          float y[8], yp[8];
          const int li = lane & 7;
#pragma unroll
          for (int e = 0; e < 8; ++e) { y[e] = f[e] * (1.0f / sqrtf(kq * (1.0f / 64) + EPS)) * kr_g[8 * li + e]; }
#pragma unroll
          for (int e = 0; e < 8; ++e) yp[e] = __shfl_xor(y[e], 4);
          if (lane < 32) { const float rstd = 1.0f / sqrtf(tot * (1.0f / 256) + EPS);
#pragma unroll
              for (int e = 0; e < 8; ++e) f[e] *= rstd;
              st8(ur + off, f);
          } else if (lane < 40) { float o[8];
#pragma unroll
              for (int e = 0; e < 8; ++e) { float cs, sn; rope_cs((float)s * a.inv_freq[8 * (li & 3) + e], cs, sn); o[e] = (li < 4) ? y[e] * cs - yp[e] * sn : y[e] * cs + yp[e] * sn; }
#pragma unroll
              for (int hh = 0; hh < 4; ++hh) st8(C.KM() + (size_t)m * 768 + hh * 192 + 128 + 8 * li, o); } }
        { up8(r_dq, f); const float rstd = 1.0f / sqrtf(grp_sum<8>(ssq8(f)) * (1.0f / 64) + EPS) * (0.125f * LOG2E);
#pragma unroll
          for (int e = 0; e < 8; ++e) f[e] *= rstd * dq_g[8 * (lane & 7) + e];
          st8(ur + U_DQ + 8 * lane, f);
          up8(r_dk, f); const float rstd2 = 1.0f / sqrtf(grp_sum<8>(ssq8(f)) * (1.0f / 64) + EPS);
#pragma unroll
          for (int e = 0; e < 8; ++e) f[e] *= rstd2 * dk_g[8 * (lane & 7) + e];
          st8(ur + U_DK + 8 * lane, f); }
        { up8(r_nq, f); const float rstd = 1.0f / sqrtf(grp_sum<16>(ssq8(f)) * (1.0f / 128) + EPS) * (0.08838834764831845f * LOG2E);
#pragma unroll
          for (int e = 0; e < 8; ++e) f[e] *= rstd * nq_g[8 * (lane & 15) + e];
          st8(ur + U_NQ + 8 * lane, f); }
        { const int grp = lane >> 4, d0 = 8 * (lane & 15); const int off = off_ms; up8(r_ms, f);
          const float q = grp_sum<16>(ssq8(f));
          if (grp >= 2) { const float* g = grp == 2 ? ks_g : kw_g; const float rstd = 1.0f / sqrtf(q * (1.0f / 128) + EPS);
#pragma unroll
              for (int e = 0; e < 8; ++e) f[e] *= rstd * g[d0 + e];
              st8(ur + off, f);
          } else { const float* pe = grp == 0 ? pe_k : pe_v; bf16_t* A = grp == 0 ? C.AK() : C.AV(); const int n1 = s >> 4, li = s & 15; float o[8];
              if (n1 == 255) {
#pragma unroll
                  for (int e = 0; e < 8; ++e) o[e] = 0.f;
                  st8(A + (size_t)(b * 256 + 255) * 4096 + li * 128 + d0, o); st8(A + (size_t)(b * 256 + 255) * 4096 + (li + 16) * 128 + d0, o);
              } else {
#pragma unroll
                  for (int e = 0; e < 8; ++e) o[e] = f[e] + pe[li * 128 + d0 + e];
                  st8(A + (size_t)(b * 256 + n1) * 4096 + li * 128 + d0, o); }
              if (n1 >= 1) {
#pragma unroll
                  for (int e = 0; e < 8; ++e) o[e] = f[e] + pe[(li + 16) * 128 + d0 + e];
                  st8(A + (size_t)(b * 256 + n1 - 1) * 4096 + (li + 16) * 128 + d0, o); } } }
    }
    for (int it = gw; it < 256 * 19; it += NGW) { const int tg = it / 19, ch = it - tg * 19;     const int m = 64 * tg + lane, b = m >> 12, s = m & 4095;
        int col; bf16_t* dst;
        if (ch < 8) { col = U_DV + 64 * ch; dst = C.VTD() + ((size_t)(b * 4 + (ch >> 1)) * 128 + 64 * (ch & 1)) * SEQ; }
        else if (ch < 10) { col = U_VS + 64 * (ch - 8); dst = C.VTVS() + ((size_t)b * 128 + 64 * (ch - 8)) * SEQ; }
        else if (ch < 12) { col = U_VW + 64 * (ch - 10); dst = C.VTVW() + ((size_t)b * 128 + 64 * (ch - 10)) * SEQ; }
        else { const int c2 = ch - 12; col = U_SV + 64 * c2; dst = C.VTS() + ((size_t)(b * 4 + (c2 >> 1)) * 128 + 64 * (c2 & 1)) * SEQ; }
        transpose64(C.U() + (size_t)m * NU + col, dst + s, SEQ); }
}
DI void fix2(const Ctx& C, int gw, int NGW, int lane) {
    const Args& a = *C.a; const int L = C.layer;
    const float* qn_g = a.in[11] + L * 128; const float* qr_g = a.in[12] + L * 64; const float* kn_g = a.in[13] + L * 128; const float* kc_g = a.in[28] + L * 128;
    const float qscale = 0.07216878364870322f * LOG2E;
    for (int m = gw; m < NTOK; m += NGW) { const int s = m & 4095; float f[8];
        bf16_t* qr = C.QM() + (size_t)m * 768;
        const u32x4 r_qn = *(const u32x4*)(qr + (lane >> 4) * 192 + 8 * (lane & 15)), r_qr = *(const u32x4*)(qr + ((lane & 31) >> 3) * 192 + 128 + 8 * (lane & 7)),
                    r_kn = *(const u32x4*)(C.KVR() + (size_t)m * 1024 + (lane >> 4) * 256 + 8 * (lane & 15));
        { const int hd = lane >> 4, d0 = 8 * (lane & 15); up8(r_qn, f); const float rstd = 1.0f / sqrtf(grp_sum<16>(ssq8(f)) * (1.0f / 128) + EPS) * qscale;
#pragma unroll
          for (int e = 0; e < 8; ++e) f[e] *= rstd * qn_g[d0 + e];
          st8(qr + hd * 192 + d0, f); }
        { const int l5 = lane & 31, hd = l5 >> 3, li = l5 & 7; up8(r_qr, f); const float rstd = 1.0f / sqrtf(grp_sum<8>(ssq8(f)) * (1.0f / 64) + EPS);
          float y[8], yp[8], o[8];
#pragma unroll
          for (int e = 0; e < 8; ++e) y[e] = f[e] * rstd * qr_g[8 * li + e];
#pragma unroll
          for (int e = 0; e < 8; ++e) yp[e] = __shfl_xor(y[e], 4);
#pragma unroll
          for (int e = 0; e < 8; ++e) { float cs, sn; rope_cs((float)s * a.inv_freq[8 * (li & 3) + e], cs, sn); o[e] = ((li < 4) ? y[e] * cs - yp[e] * sn : y[e] * cs + yp[e] * sn) * qscale; }
          if (lane < 32) st8(qr + hd * 192 + 128 + 8 * li, o); }
        { const int hd = lane >> 4, d0 = 8 * (lane & 15); up8(r_kn, f); const float rstd = 1.0f / sqrtf(grp_sum<16>(ssq8(f)) * (1.0f / 128) + EPS);
#pragma unroll
          for (int e = 0; e < 8; ++e) f[e] *= rstd * kn_g[d0 + e];
          st8(C.KM() + (size_t)m * 768 + hd * 192 + d0, f); }
    }
    for (int r4 = gw; r4 < 256; r4 += NGW) { const int row = 4 * r4 + (lane >> 4), d0 = 8 * (lane & 15); float f[8]; ld8(C.KC() + (size_t)row * 128 + d0, f);
        const float rstd = 1.0f / sqrtf(grp_sum<16>(ssq8(f)) * (1.0f / 128) + EPS);
#pragma unroll
        for (int e = 0; e < 8; ++e) f[e] *= rstd * kc_g[d0 + e];
        st8(C.KC() + (size_t)row * 128 + d0, f); }
    for (int it = gw; it < 256 * 8 + 32 + 256; it += NGW) {
        if (it >= 2080) { const int tg = it - 2080; const int m = 64 * tg + lane, b = m >> 12, s = m & 4095;
            transpose64(C.U() + (size_t)m * NU + 5120, C.VTS() + ((size_t)(b * 4 + 3) * 128 + 64) * SEQ + s, SEQ);
        } else if (it < 2048) { const int tg = it >> 3, ch = it & 7; const int m = 64 * tg + lane, b = m >> 12, s = m & 4095;
            transpose64(C.KVR() + (size_t)m * 1024 + (ch >> 1) * 256 + 128 + 64 * (ch & 1), C.VTM() + ((size_t)(b * 4 + (ch >> 1)) * 128 + 64 * (ch & 1)) * SEQ + s, SEQ);
        } else { const int i2 = it - 2048, rg = i2 >> 1, ch = i2 & 1; const int row = 64 * rg + lane, b = row >> 8, n = row & 255;
            transpose64(C.VCR() + (size_t)row * 128 + 64 * ch, C.VTVC() + ((size_t)b * 128 + 64 * ch) * 256 + n, 256); }
    }
}

namespace att {
constexpr float NEG = -1e30f;
constexpr int VP = 72;
constexpr int OFF_K = 0, OFF_V = 25600, OFF_WS = OFF_V + 128 * VP * 2  , OFF_IMP = OFF_WS + 8 * 256  , OFF_SEL = OFF_IMP + 65536  ,
              OFF_MISC = OFF_SEL + 512  , LDS_END = OFF_MISC + 64;
DI int crow(int reg, int h) { return (reg & 3) + 8 * (reg >> 2) + 4 * h; }
#define MFMA32(a, b, c) __builtin_amdgcn_mfma_f32_32x32x16_bf16((a), (b), (c), 0, 0, 0)

struct Pre { u32x4 k[3]; u32x4 v[2]; };
template <int DK> DI void prefetch(int tid, Pre& P, const bf16_t* kg, size_t kpitch, const bf16_t* vg, size_t vpitch, bool with_v) {
    constexpr int PPR = DK / 8;
#pragma unroll
    for (int i = 0; i < (64 * PPR) / 512; ++i) { const int p = tid + i * 512; const int r = p / PPR, c = p - r * PPR; P.k[i] = *(const u32x4*)(kg + (size_t)r * kpitch + c * 8); }
    if (with_v) {
#pragma unroll
        for (int i = 0; i < 2; ++i) { const int p = tid + i * 512; const int r = p >> 3, c = p & 7; P.v[i] = *(const u32x4*)(vg + (size_t)r * vpitch + c * 8); } }
}
template <int DK> DI void commit(int tid, const Pre& P, LAS unsigned char* lds, bool with_v) {
    constexpr int PPR = DK / 8, KP = DK + 8;
#pragma unroll
    for (int i = 0; i < (64 * PPR) / 512; ++i) { const int p = tid + i * 512; const int r = p / PPR, c = p - r * PPR; *(LAS u32x4*)(lds + OFF_K + (r * KP + c * 8) * 2) = P.k[i]; }
    if (with_v) {
#pragma unroll
        for (int i = 0; i < 2; ++i) { const int p = tid + i * 512; const int r = p >> 3, c = p & 7; *(LAS u32x4*)(lds + OFF_V + (r * VP + c * 8) * 2) = P.v[i]; } }
}
template <int DK> DI void qk(f32x16& p0, f32x16& p1, const LAS unsigned char* lds, const bf16x8 (&qf)[DK / 16], int r, int h, float slope2 = 0.f, float b0 = 0.f) {
    constexpr int KP = DK + 8;
    const LAS unsigned char* k0 = lds + OFF_K + (r * KP + 8 * h) * 2; const LAS unsigned char* k1 = k0 + 32 * KP * 2;
#pragma unroll
    for (int e = 0; e < 16; ++e) { p0[e] = fmaf(slope2, (float)((e & 3) + 8 * (e >> 2)), b0); p1[e] = fmaf(slope2, (float)((e & 3) + 8 * (e >> 2) + 32), b0); }
#pragma unroll
    for (int ks = 0; ks < DK / 16; ++ks) { const bf16x8 a0 = *(const LAS bf16x8*)(k0 + ks * 32); const bf16x8 a1 = *(const LAS bf16x8*)(k1 + ks * 32);
        p0 = MFMA32(a0, qf[ks], p0); p1 = MFMA32(a1, qf[ks], p1); }
}
DI bf16x8 pack8(const f32x16& x, int s) {
    u32x4 p; p.x = pk2(x[8 * s], x[8 * s + 1]); p.y = pk2(x[8 * s + 2], x[8 * s + 3]); p.z = pk2(x[8 * s + 4], x[8 * s + 5]); p.w = pk2(x[8 * s + 6], x[8 * s + 7]);
    return __builtin_bit_cast(bf16x8, p); }
DI void pv(f32x16 (&o)[4], const f32x16& p0, const f32x16& p1, const LAS unsigned char* lds, int r, int h) {
    const LAS unsigned char* vb = lds + OFF_V + (r * VP + 4 * h) * 2;
#pragma unroll
    for (int sp = 0; sp < 4; ++sp) { const bf16x8 pa = (sp < 2) ? pack8(p0, sp & 1) : pack8(p1, sp & 1);
#pragma unroll
        for (int db = 0; db < 4; ++db) { const LAS unsigned char* vr = vb + db * 32 * VP * 2 + sp * 32;
            const s16x4 lo = *(const LAS s16x4*)(vr); const s16x4 hi = *(const LAS s16x4*)(vr + 16);
            const bf16x8 vv = __builtin_shufflevector(lo, hi, 0, 1, 2, 3, 4, 5, 6, 7);
            o[db] = MFMA32(pa, vv, o[db]); } }
}
DI void scale_rows(f32x16 (&o)[4], float fac, LAS float* wsf, int r, int h) {
    if (h == 0) wsf[r] = fac;
    LDS_WAIT(); __builtin_amdgcn_wave_barrier();
#pragma unroll
    for (int g = 0; g < 4; ++g) { const f32x4 f4 = *(const LAS f32x4*)(wsf + 8 * g + 4 * h);
#pragma unroll
        for (int db = 0; db < 4; ++db) { o[db][4 * g] *= f4.x; o[db][4 * g + 1] *= f4.y; o[db][4 * g + 2] *= f4.z; o[db][4 * g + 3] *= f4.w; } }
    LDS_WAIT(); __builtin_amdgcn_wave_barrier();
}
DI void stash_store(float* st, const f32x16 (&o)[4], int tid) { f32x4* p = (f32x4*)(st + tid * 64);
#pragma unroll
    for (int db = 0; db < 4; ++db)
#pragma unroll
        for (int g = 0; g < 4; ++g) p[db * 4 + g] = (f32x4){o[db][4 * g], o[db][4 * g + 1], o[db][4 * g + 2], o[db][4 * g + 3]}; }
DI void stash_add(const float* st, f32x16 (&o)[4], int tid) { const f32x4* p = (const f32x4*)(st + tid * 64);
#pragma unroll
    for (int db = 0; db < 4; ++db)
#pragma unroll
        for (int g = 0; g < 4; ++g) { const f32x4 v = p[db * 4 + g]; o[db][4 * g] += v.x; o[db][4 * g + 1] += v.y; o[db][4 * g + 2] += v.z; o[db][4 * g + 3] += v.w; } }
DI float max32(const f32x16& p0, const f32x16& p1) { float a = fmaxf(p0[0], p1[0]);
#pragma unroll
    for (int e = 1; e < 16; ++e) a = fmaxf(a, fmaxf(p0[e], p1[e]));
    return fmaxf(a, __shfl_xor(a, 32)); }
DI void softmax_step(f32x16& p0, f32x16& p1, float& m, float& l, f32x16 (&o)[4], LAS float* wsf, int r, int h, bool has_o) {
    const float mn = fmaxf(m, max32(p0, p1)); const float mu = (mn < 0.5f * NEG) ? 0.f : mn; const float f = __builtin_amdgcn_exp2f(m - mu);
    float s = 0.f;
#pragma unroll
    for (int e = 0; e < 16; ++e) { p0[e] = __builtin_amdgcn_exp2f(p0[e] - mu); p1[e] = __builtin_amdgcn_exp2f(p1[e] - mu); s += p0[e] + p1[e]; }
    l = l * f + s; m = mn;
    if (has_o && __any(f != 1.0f)) scale_rows(o, f, wsf, r, h);
}
DI void finish_write(const f32x16 (&o)[4], const float* gain, float extra, bf16_t* out, size_t pitch, int r, int h) {
    float g[4];
#pragma unroll
    for (int db = 0; db < 4; ++db) g[db] = gain[r + 32 * db] * extra;
#pragma unroll
    for (int reg = 0; reg < 16; ++reg) { float ss = o[0][reg] * o[0][reg] + o[1][reg] * o[1][reg] + o[2][reg] * o[2][reg] + o[3][reg] * o[3][reg];
        ss += __shfl_xor(ss, 1); ss += __shfl_xor(ss, 2); ss += __shfl_xor(ss, 4); ss += __shfl_xor(ss, 8); ss += __shfl_xor(ss, 16);
        const float rstd = 1.0f / sqrtf(ss * (1.0f / 128) + EPS); bf16_t* orow = out + (size_t)crow(reg, h) * pitch + r;
#pragma unroll
        for (int db = 0; db < 4; ++db) orow[32 * db] = (bf16_t)(pk2(o[db][reg] * rstd * g[db], 0.f) & 0xffffu); }
}
DI void zero_o(f32x16 (&o)[4]) {
#pragma unroll
    for (int db = 0; db < 4; ++db)
#pragma unroll
        for (int e = 0; e < 16; ++e) o[db][e] = 0.f; }
DI void causal_mask(f32x16& p0, f32x16& p1, int kv0, int t, int h) {
    const int d0 = kv0 + 4 * h - t;
#pragma unroll
    for (int e = 0; e < 16; ++e) { const int dk = d0 + (e & 3) + 8 * (e >> 2); if (dk > 0) p0[e] = NEG; if (dk + 32 > 0) p1[e] = NEG; }
}
DI void unit_mla(LAS unsigned char* lds, const Ctx& C, int b, int hd, int qb) {
    const int tid = otid(), lane = tid & 63, w = __builtin_amdgcn_readfirstlane(tid >> 6), r = lane & 31, h = lane >> 5;
    LAS float* wsf = (LAS float*)(lds + OFF_WS + w * 256);
    const int t0 = qb * 256 + w * 32, t = t0 + r; const size_t tok = (size_t)b * SEQ + t;
    bf16x8 qf[12];
#pragma unroll
    for (int ks = 0; ks < 12; ++ks) qf[ks] = *(const bf16x8*)(C.QM() + tok * 768 + hd * 192 + 16 * ks + 8 * h);
    const bf16_t* kbase = C.KM() + (size_t)b * SEQ * 768 + hd * 192; const bf16_t* vbase = C.VTM() + (size_t)((b * 4 + hd) * 128) * SEQ;
    f32x16 o[4]; zero_o(o); float m = NEG, l = 0.f; const int nt = 4 * qb + 4;
    Pre P; prefetch<192>(tid, P, kbase, 768, vbase, SEQ, true);
    for (int j = 0; j < nt; ++j) {
        __syncthreads(); commit<192>(tid, P, lds, true); __syncthreads();
        if (j + 1 < nt) prefetch<192>(tid, P, kbase + (size_t)(j + 1) * 64 * 768, 768, vbase + (j + 1) * 64, SEQ, true);
        const int kv0 = 64 * j;
        if (kv0 <= t0 + 31) { f32x16 p0, p1; qk<192>(p0, p1, lds, qf, r, h);
            if (kv0 + 63 > t0) causal_mask(p0, p1, kv0, t, h);
            softmax_step(p0, p1, m, l, o, wsf, r, h, true); pv(o, p0, p1, lds, r, h); }
    }
    l += __shfl_xor(l, 32); scale_rows(o, 1.0f / fmaxf(l, 1e-30f), wsf, r, h);
    finish_write(o, C.a->in[15] + C.layer * 128, 1.f, C.MIX() + ((size_t)b * SEQ + t0) * DM + hd * 128, DM, r, h);
}
DI bool diff_fixed_ok(const Ctx& C) { const int lane = otid() & 63; const Args& a = *C.a; float gq = fabsf(a.in[16][C.layer * 64 + lane]), gk = fabsf(a.in[17][C.layer * 64 + lane]);
#pragma unroll
    for (int of = 1; of < 64; of <<= 1) { gq = fmaxf(gq, __shfl_xor(gq, of)); gk = fmaxf(gk, __shfl_xor(gk, of)); }
    return __builtin_amdgcn_readfirstlane((8.1f * gq * 0.125f * LOG2E) * (8.1f * gk) < 45.0f ? 1 : 0) != 0; }
template <bool FIXED> DI void unit_diff(LAS unsigned char* lds, const Ctx& C, int b, int hd, int qb) {
    const int tid = otid(), lane = tid & 63, w = __builtin_amdgcn_readfirstlane(tid >> 6), r = lane & 31, h = lane >> 5;
    LAS float* wsf = (LAS float*)(lds + OFF_WS + w * 256); const Args& a = *C.a; const int L = C.layer;
    LAS int* votes = (LAS int*)(lds + OFF_MISC + 16);
    const float lam_init = 0.8f - 0.6f * expf(-0.3f * (float)L);
    const float lam = expf(wave_sum(a.in[18][L * 64 + lane] * a.in[19][L * 64 + lane])) - expf(wave_sum(a.in[20][L * 64 + lane] * a.in[21][L * 64 + lane])) + lam_init;
    const float slope2 = exp2f(-(float)(2 * hd + 1)) * LOG2E;
    float kmax = fabsf(a.in[17][L * 64 + lane]);
#pragma unroll
    for (int of = 1; of < 64; of <<= 1) kmax = fmaxf(kmax, __shfl_xor(kmax, of));
    kmax *= 8.1f;
    const int t0 = qb * 256 + w * 32, t = t0 + r; const size_t tok = (size_t)b * SEQ + t;
    const bf16_t* vbase = C.VTD() + (size_t)((b * 4 + hd) * 128) * SEQ;
    float* stash = (float*)(C.ws + WS_STASH) + (size_t)blockIdx.x * 32768; const int nt = 4 * qb + 4;
    f32x16 o[4];
#pragma unroll 1
    for (int which = 0; which < 2; ++which) {
        bf16x8 qf[4]; float qn = 0.f;
#pragma unroll
        for (int ks = 0; ks < 4; ++ks) { qf[ks] = *(const bf16x8*)(C.U() + tok * NU + U_DQ + hd * 128 + which * 64 + 16 * ks + 8 * h);
#pragma unroll
            for (int e = 0; e < 8; ++e) { const float x = bf2f((unsigned)(unsigned short)qf[ks][e]); qn += x * x; } }
        qn += __shfl_xor(qn, 32); const float bq = sqrtf(qn) * kmax;
        const bf16_t* kbase = C.U() + (size_t)b * SEQ * NU + U_DK + hd * 128 + which * 64;
        zero_o(o); float m = NEG, l = 0.f;
        Pre P; prefetch<64>(tid, P, kbase + (size_t)(nt - 1) * 64 * NU, NU, vbase + (nt - 1) * 64, SEQ, true);
        for (int j = nt - 1; j >= 0; --j) {
            __syncthreads();
            if (j < nt - 1) { int alld = 1;
#pragma unroll
                for (int i = 0; i < 8; ++i) alld &= votes[i];
                if (__builtin_amdgcn_readfirstlane(alld)) break; }
            commit<64>(tid, P, lds, true); __syncthreads();
            if (j > 0) prefetch<64>(tid, P, kbase + (size_t)(j - 1) * 64 * NU, NU, vbase + (j - 1) * 64, SEQ, true);
            const int kv0 = 64 * j;
            if (kv0 <= t0 + 31) { f32x16 p0, p1; qk<64>(p0, p1, lds, qf, r, h, slope2, slope2 * (float)(kv0 + 4 * h - t) - (FIXED ? bq : 0.f));
                if (kv0 + 63 > t0) causal_mask(p0, p1, kv0, t, h);
                if constexpr (FIXED) {
                    float sacc = 0.f;
#pragma unroll
                    for (int e = 0; e < 16; ++e) { p0[e] = __builtin_amdgcn_exp2f(p0[e]); p1[e] = __builtin_amdgcn_exp2f(p1[e]); sacc += p0[e] + p1[e]; }
                    l += sacc; m = bq;
                } else softmax_step(p0, p1, m, l, o, wsf, r, h, true);
                pv(o, p0, p1, lds, r, h); }
            { const bool dn = (m > 0.5f * NEG) && (bq - slope2 * (float)(t - kv0 + 1) - m < -160.0f); const int av = __all(dn) ? 1 : 0; if (lane == 0) votes[w] = av; }
        }
        l += __shfl_xor(l, 32); scale_rows(o, (which == 0 ? 1.0f : -lam) / fmaxf(l, 1e-30f), wsf, r, h);
        if (which == 0) stash_store(stash, o, tid); else stash_add(stash, o, tid);
    }
    finish_write(o, a.in[22] + L * 128, 1.0f - lam_init, C.MIX() + ((size_t)b * SEQ + t0) * DM + 512 + hd * 128, DM, r, h);
}
DI float softplus2(float z) { return fmaxf(z, 0.f) + __builtin_amdgcn_logf(1.0f + __builtin_amdgcn_exp2f(-fabsf(z))); }
DI void unit_sb(LAS unsigned char* lds, const Ctx& C, int b, int hd, int qb) {
    const int tid = otid(), lane = tid & 63, w = __builtin_amdgcn_readfirstlane(tid >> 6), r = lane & 31, h = lane >> 5;
    const int t0 = qb * 256 + w * 32, t = t0 + r; const size_t tok = (size_t)b * SEQ + t;
    bf16x8 qf[8];
#pragma unroll
    for (int ks = 0; ks < 8; ++ks) qf[ks] = *(const bf16x8*)(C.U() + tok * NU + U_SQ + hd * 128 + 16 * ks + 8 * h);
    const bf16_t* kbase = C.U() + (size_t)b * SEQ * NU + U_SK + hd * 128; const bf16_t* vbase = C.VTS() + (size_t)((b * 4 + hd) * 128) * SEQ;
    f32x16 o[4]; zero_o(o); float cum = 0.f;
    const int nt = 4 * qb + 4;
    Pre P; prefetch<128>(tid, P, kbase + (size_t)(nt - 1) * 64 * NU, NU, vbase + (nt - 1) * 64, SEQ, true);
    LAS int* votes = (LAS int*)(lds + OFF_MISC + 16);
    for (int j = nt - 1; j >= 0; --j) {
        __syncthreads();
        if (j < nt - 1) { int alld = 1;
#pragma unroll
            for (int i = 0; i < 8; ++i) alld &= votes[i];
            if (__builtin_amdgcn_readfirstlane(alld)) break; }
        commit<128>(tid, P, lds, true); __syncthreads();
        if (j > 0) prefetch<128>(tid, P, kbase + (size_t)(j - 1) * 64 * NU, NU, vbase + (j - 1) * 64, SEQ, true);
        const int kv0 = 64 * j;
        if (kv0 < t0 + 31) { f32x16 p0, p1; qk<128>(p0, p1, lds, qf, r, h);
            const int d0 = kv0 + 4 * h - t; f32x16 s0, s1;
#pragma unroll
            for (int e = 0; e < 16; ++e) { const int dk = d0 + (e & 3) + 8 * (e >> 2); s0[e] = (dk < 0) ? softplus2(p0[e]) : 0.f; s1[e] = (dk + 32 < 0) ? softplus2(p1[e]) : 0.f; }
            float Gs[8], Go[8];
#pragma unroll
            for (int k = 0; k < 4; ++k) { Gs[k] = (s0[4 * k] + s0[4 * k + 1]) + (s0[4 * k + 2] + s0[4 * k + 3]); Gs[k + 4] = (s1[4 * k] + s1[4 * k + 1]) + (s1[4 * k + 2] + s1[4 * k + 3]); }
#pragma unroll
            for (int k = 0; k < 8; ++k) Go[k] = __shfl_xor(Gs[k], 32);
            float T = 0.f;
#pragma unroll
            for (int k = 7; k >= 0; --k) { float base = cum - T - (h == 0 ? Go[k] : 0.f);
                if (k < 4) {
                    float e3 = base;            float e2 = e3 - s0[4 * k + 3]; float e1 = e2 - s0[4 * k + 2]; float e0 = e1 - s0[4 * k + 1];
                    const int dk = d0 + 8 * k;
                    p0[4 * k + 3] = (dk + 3 < 0) ? __builtin_amdgcn_exp2f(p0[4 * k + 3] - s0[4 * k + 3] + e3) : 0.f;
                    p0[4 * k + 2] = (dk + 2 < 0) ? __builtin_amdgcn_exp2f(p0[4 * k + 2] - s0[4 * k + 2] + e2) : 0.f;
                    p0[4 * k + 1] = (dk + 1 < 0) ? __builtin_amdgcn_exp2f(p0[4 * k + 1] - s0[4 * k + 1] + e1) : 0.f;
                    p0[4 * k + 0] = (dk + 0 < 0) ? __builtin_amdgcn_exp2f(p0[4 * k + 0] - s0[4 * k + 0] + e0) : 0.f;
                } else { const int kk = k - 4;
                    float e3 = base;            float e2 = e3 - s1[4 * kk + 3]; float e1 = e2 - s1[4 * kk + 2]; float e0 = e1 - s1[4 * kk + 1];
                    const int dk = d0 + 8 * k;
                    p1[4 * kk + 3] = (dk + 3 < 0) ? __builtin_amdgcn_exp2f(p1[4 * kk + 3] - s1[4 * kk + 3] + e3) : 0.f;
                    p1[4 * kk + 2] = (dk + 2 < 0) ? __builtin_amdgcn_exp2f(p1[4 * kk + 2] - s1[4 * kk + 2] + e2) : 0.f;
                    p1[4 * kk + 1] = (dk + 1 < 0) ? __builtin_amdgcn_exp2f(p1[4 * kk + 1] - s1[4 * kk + 1] + e1) : 0.f;
                    p1[4 * kk + 0] = (dk + 0 < 0) ? __builtin_amdgcn_exp2f(p1[4 * kk + 0] - s1[4 * kk + 0] + e0) : 0.f; }
                T += Gs[k] + Go[k]; }
            cum -= T;
            pv(o, p0, p1, lds, r, h); }
        { const int dn = __all(cum < -160.0f) ? 1 : 0; if (lane == 0) votes[w] = dn; }
    }
    finish_write(o, C.a->in[32] + C.layer * 128, 1.f, C.MIX() + ((size_t)b * SEQ + t0) * DM + 1536 + hd * 128, DM, r, h);
}
DI void cmp_bias_mask(f32x16& p0, f32x16& p1, int n0, int t, int h, float slope2) {
    const int c0 = 16 * (n0 + 4 * h) + 31 - t;
#pragma unroll
    for (int e = 0; e < 16; ++e) { const int ce = c0 + 16 * ((e & 3) + 8 * (e >> 2));
        p0[e] = (ce > 0) ? NEG : fmaf(slope2, (float)ce, p0[e]); p1[e] = (ce + 512 > 0) ? NEG : fmaf(slope2, (float)(ce + 512), p1[e]); }
}
DI void unit_nsa(LAS unsigned char* lds, const Ctx& C, int b, int qb) {
    const int tid = otid(), lane = tid & 63, w = __builtin_amdgcn_readfirstlane(tid >> 6), r = lane & 31, h = lane >> 5, hd = w >> 1, qh = w & 1;
    LAS float* wsf = (LAS float*)(lds + OFF_WS + w * 256); LAS float* imp = (LAS float*)(lds + OFF_IMP); LAS unsigned long long* sel = (LAS unsigned long long*)(lds + OFF_SEL);
    const int t0 = qb * 64 + qh * 32, t = t0 + r, ql = qh * 32 + r; const size_t tok = (size_t)b * SEQ + t;
    bf16x8 qf[8];
#pragma unroll
    for (int ks = 0; ks < 8; ++ks) qf[ks] = *(const bf16x8*)(C.U() + tok * NU + U_NQ + hd * 128 + 16 * ks + 8 * h);
    const bf16_t* gp = C.U() + tok * NU + U_G + hd * 3;
    const float g0 = 1.0f / (1.0f + __expf(-bf2f(gp[0]))), g1 = 1.0f / (1.0f + __expf(-bf2f(gp[1]))), g2 = 1.0f / (1.0f + __expf(-bf2f(gp[2])));
    const float slope2 = exp2f(-(float)(2 * hd + 2)) * LOG2E;
    for (int i = tid; i < 16384; i += 512) imp[i] = 0.f;
    float* stash = (float*)(C.ws + WS_STASH) + (size_t)blockIdx.x * 32768; f32x16 o[4]; Pre P;
    const bf16_t* kcb = C.KC() + (size_t)b * 256 * 128; const bf16_t* vcb = C.VTVC() + (size_t)b * 128 * 256; const int ntc = (4 * qb + 2) / 64 + 1;
    float m = NEG, l = 0.f;
    prefetch<128>(tid, P, kcb, 128, vcb, 256, false);
    for (int j = 0; j < ntc; ++j) {
        __syncthreads(); commit<128>(tid, P, lds, false); __syncthreads();
        if (j + 1 < ntc) prefetch<128>(tid, P, kcb + (size_t)(j + 1) * 64 * 128, 128, vcb, 256, false);
        f32x16 p0, p1; qk<128>(p0, p1, lds, qf, r, h); cmp_bias_mask(p0, p1, 64 * j, t, h, slope2); softmax_step(p0, p1, m, l, o, wsf, r, h, false);
    }
    l += __shfl_xor(l, 32);
    { const float mu = (m < 0.5f * NEG) ? 0.f : m; const float il = 1.0f / fmaxf(l, 1e-30f);
      zero_o(o); prefetch<128>(tid, P, kcb, 128, vcb, 256, true);
      for (int j = 0; j < ntc; ++j) {
          __syncthreads(); commit<128>(tid, P, lds, true); __syncthreads();
          if (j + 1 < ntc) prefetch<128>(tid, P, kcb + (size_t)(j + 1) * 64 * 128, 128, vcb + (j + 1) * 64, 256, true);
          f32x16 p0, p1; qk<128>(p0, p1, lds, qf, r, h); cmp_bias_mask(p0, p1, 64 * j, t, h, slope2);
#pragma unroll
          for (int e = 0; e < 16; ++e) { p0[e] = __builtin_amdgcn_exp2f(p0[e] - mu) * il; p1[e] = __builtin_amdgcn_exp2f(p1[e] - mu) * il; }
#pragma unroll
          for (int g = 0; g < 4; ++g) { const int jb = 16 * j + 2 * g + h; LAS float* ip = imp + hd * 4096 + ql * 64 + jb;
              __hip_atomic_fetch_add(ip, (p0[4 * g] + p0[4 * g + 1]) + (p0[4 * g + 2] + p0[4 * g + 3]), __ATOMIC_RELAXED, __HIP_MEMORY_SCOPE_WORKGROUP);
              __hip_atomic_fetch_add(ip + 1, p0[4 * g + 3], __ATOMIC_RELAXED, __HIP_MEMORY_SCOPE_WORKGROUP);
              __hip_atomic_fetch_add(ip + 8, (p1[4 * g] + p1[4 * g + 1]) + (p1[4 * g + 2] + p1[4 * g + 3]), __ATOMIC_RELAXED, __HIP_MEMORY_SCOPE_WORKGROUP);
              if (jb + 9 < 64) __hip_atomic_fetch_add(ip + 9, p1[4 * g + 3], __ATOMIC_RELAXED, __HIP_MEMORY_SCOPE_WORKGROUP); }
          pv(o, p0, p1, lds, r, h);
      }
      scale_rows(o, g0, wsf, r, h); stash_store(stash, o, tid); }
    __syncthreads();
    for (int qi = 0; qi < 8; ++qi) { const int q = 8 * w + qi; const float v = ((imp[q * 64 + lane] + imp[4096 + q * 64 + lane]) + imp[8192 + q * 64 + lane]) + imp[12288 + q * 64 + lane];
        const bool valid = lane <= qb, forced = (lane == 0) || (lane == qb) || (lane == qb - 1); const float key = forced ? 3.0e38f : v; int rank = 0;
        for (int jj = 0; jj <= qb; ++jj) { const float kj = __shfl(key, jj); rank += ((kj > key) || (kj == key && jj < lane)) ? 1 : 0; }
        const unsigned long long mk = __ballot(valid && rank < 16);
        if (lane == 0) sel[q] = mk; }
    __syncthreads();
    const unsigned long long selq = sel[ql];
    unsigned long long un;
    { unsigned long long u = sel[lane]; unsigned lo = (unsigned)u, hi = (unsigned)(u >> 32);
#pragma unroll
      for (int of = 1; of < 64; of <<= 1) { lo |= __shfl_xor(lo, of); hi |= __shfl_xor(hi, of); }
      un = ((unsigned long long)(unsigned)__builtin_amdgcn_readfirstlane((int)hi) << 32) | (unsigned long long)(unsigned)__builtin_amdgcn_readfirstlane((int)lo); }
    { const bf16_t* kb = C.U() + (size_t)b * SEQ * NU + U_KS; const bf16_t* vb = C.VTVS() + (size_t)b * 128 * SEQ;
      m = NEG; l = 0.f; zero_o(o); unsigned long long rem = un;
      if (rem) { const int j0 = __builtin_ctzll(rem); prefetch<128>(tid, P, kb + (size_t)j0 * 64 * NU, NU, vb + j0 * 64, SEQ, true); }
      while (rem) { const int j = __builtin_ctzll(rem); rem &= rem - 1;
          __syncthreads(); commit<128>(tid, P, lds, true); __syncthreads();
          if (rem) { const int jn = __builtin_ctzll(rem); prefetch<128>(tid, P, kb + (size_t)jn * 64 * NU, NU, vb + jn * 64, SEQ, true); }
          const bool mine = (selq >> j) & 1ull;
          if (__any(mine)) { f32x16 p0, p1; qk<128>(p0, p1, lds, qf, r, h, slope2, slope2 * (float)(64 * j + 4 * h - t)); if (64 * j + 63 > t0) causal_mask(p0, p1, 64 * j, t, h);
              if (!mine) {
#pragma unroll
                  for (int e = 0; e < 16; ++e) { p0[e] = NEG; p1[e] = NEG; } }
              softmax_step(p0, p1, m, l, o, wsf, r, h, true); pv(o, p0, p1, lds, r, h); }
      }
      l += __shfl_xor(l, 32); scale_rows(o, g1 / fmaxf(l, 1e-30f), wsf, r, h); stash_add(stash, o, tid); stash_store(stash, o, tid); }
    { const bf16_t* kb = C.U() + (size_t)b * SEQ * NU + U_KW; const bf16_t* vb = C.VTVW() + (size_t)b * 128 * SEQ;
      m = NEG; l = 0.f; zero_o(o); const int jlo = qb > 8 ? qb - 8 : 0;
      prefetch<128>(tid, P, kb + (size_t)jlo * 64 * NU, NU, vb + jlo * 64, SEQ, true);
      for (int j = jlo; j <= qb; ++j) {
          __syncthreads(); commit<128>(tid, P, lds, true); __syncthreads();
          if (j < qb) prefetch<128>(tid, P, kb + (size_t)(j + 1) * 64 * NU, NU, vb + (j + 1) * 64, SEQ, true);
          const int d0 = 64 * j + 4 * h - t;
          f32x16 p0, p1; qk<128>(p0, p1, lds, qf, r, h, slope2, slope2 * (float)d0);
          if (j == qb || j + 8 <= qb) {
#pragma unroll
              for (int e = 0; e < 16; ++e) { const int dk = d0 + (e & 3) + 8 * (e >> 2);
                  if (dk > 0 || dk <= -512) p0[e] = NEG; if (dk + 32 > 0 || dk + 32 <= -512) p1[e] = NEG; } }
          softmax_step(p0, p1, m, l, o, wsf, r, h, true); pv(o, p0, p1, lds, r, h);
      }
      l += __shfl_xor(l, 32); scale_rows(o, g2 / fmaxf(l, 1e-30f), wsf, r, h); stash_add(stash, o, tid); }
    finish_write(o, C.a->in[31] + C.layer * 128, 1.f, C.MIX() + ((size_t)b * SEQ + t0) * DM + 1024 + hd * 128, DM, r, h);
}
DI void attn_phase(LAS unsigned char* lds, const Ctx& C, unsigned* ctr) {
    LAS int* misc = (LAS int*)(lds + OFF_MISC);
    for (;;) {
        __syncthreads();
        if (otid() == 0) misc[0] = (int)__hip_atomic_fetch_add(ctr, 1u, __ATOMIC_RELAXED, __HIP_MEMORY_SCOPE_AGENT);
        __syncthreads();
        const int p = __builtin_amdgcn_readfirstlane(misc[0]);
        if (p >= 1024) break;
        int type, bh, qb;
        if (p < 256) { type = 3; qb = 63 - (p >> 2); bh = p & 3; }
        else { const int pp = p - 256, g = pp / 48, q = pp - 48 * g; qb = 15 - g; type = q >> 4; bh = q & 15; }
#ifndef NO_DIFF
        if (type == 0) { if (diff_fixed_ok(C)) unit_diff<true>(lds, C, bh >> 2, bh & 3, qb); else unit_diff<false>(lds, C, bh >> 2, bh & 3, qb); }
#endif
#ifndef NO_SB
        if (type == 1) unit_sb(lds, C, bh >> 2, bh & 3, qb);
#endif
#ifndef NO_MLA
        if (type == 2) unit_mla(lds, C, bh >> 2, bh & 3, qb);
#endif
#ifndef NO_NSA
        if (type == 3) unit_nsa(lds, C, bh, qb);
#endif
    }
}
}

#ifndef PROBE_SEAM
#define PROBE_SEAM 0
#endif
#ifndef PROBE_SPIN
#define PROBE_SPIN 0
#endif
#ifndef PROBE_DOUBLE
#define PROBE_DOUBLE 0
#endif
#ifndef PHMASK
#define PHMASK 0xffffffffu
#endif
constexpr int LDS_BYTES = 147456;
static_assert(att::LDS_END <= 131072, "attention LDS map");
#define RLX_AGENT __ATOMIC_RELAXED, __HIP_MEMORY_SCOPE_AGENT
#define XB_TMO      128
#define XB_XCNT(j)  (256  + 64 * (j))
#define XB_XSUB(j)  (1280 + 64 * (j))
#define XB_XGEN(j)  (2304 + 64 * (j))
#define XB_TOP      3328
#define XB_TOPGEN   3392
#define XCD_BAR_WORDS 3456
#define XB_SPIN_CAP (1u << 18)

__device__ __forceinline__ unsigned xb_ld(unsigned* p)              { return __hip_atomic_load(p, __ATOMIC_RELAXED, __HIP_MEMORY_SCOPE_AGENT); }
__device__ __forceinline__ unsigned xb_add(unsigned* p, unsigned v) { return __hip_atomic_fetch_add(p, v, __ATOMIC_RELAXED, __HIP_MEMORY_SCOPE_AGENT); }
__device__ __forceinline__ unsigned xb_xcc_id() { return (unsigned)__builtin_amdgcn_s_getreg((3 << 11) | 20) & 0xFu; }
#define XB_SPIN(cond, bar) do { unsigned _sp = 0; while (cond) { __builtin_amdgcn_s_sleep(1); \
    if ((++_sp & 255u) == 0u) { if (xb_ld(&(bar)[XB_TMO])) break; if (_sp > XB_SPIN_CAP) { atomicAdd(&(bar)[XB_TMO], 1u); break; } } } } while (0)

struct XcdBarrier {
    unsigned* bar; unsigned x;
    volatile LAS unsigned* st;
};

__device__ __forceinline__ XcdBarrier xcd_barrier_post(unsigned* bar, volatile LAS unsigned* st) {
    XcdBarrier b; b.bar = bar; b.x = xb_xcc_id(); b.st = st;
    if (threadIdx.x == 0) (void)xb_add(&bar[XB_XCNT(b.x)], 1u);
    return b;
}
__device__ __forceinline__ void xcd_barrier_complete(unsigned* bar, unsigned x, unsigned& nloc, unsigned& nx) {
    const unsigned G = gridDim.x * gridDim.y * gridDim.z;
    unsigned sum, cnt, mine, sp = 0u;
    for (;;) {
        sum = 0u; cnt = 0u; mine = 0u;
#pragma unroll
        for (unsigned j = 0; j < 16; ++j) { const unsigned c = xb_ld(&bar[XB_XCNT(j)]); sum += c; cnt += (c > 0u) ? 1u : 0u; mine = (j == x) ? c : mine; }
        if (sum == G) break;
        __builtin_amdgcn_s_sleep(1);
        if ((++sp & 255u) == 0u) { if (xb_ld(&bar[XB_TMO])) break; if (sp > XB_SPIN_CAP) { atomicAdd(&bar[XB_TMO], 1u); break; } }
    }
    nloc = mine > 0u ? mine : 1u; nx = cnt > 0u ? cnt : 1u;
}

__device__ __forceinline__ void xcd_barrier(const XcdBarrier& b) {
    asm volatile("s_waitcnt vmcnt(0)" ::: "memory");
    __syncthreads();
    if (threadIdx.x == 0) {
        unsigned* bar = b.bar;
        __builtin_amdgcn_s_waitcnt(0);
        unsigned nloc = b.st[0], nx = b.st[1];
        if (nloc == 0u) { xcd_barrier_complete(bar, b.x, nloc, nx); b.st[0] = nloc; b.st[1] = nx; }
        const unsigned old = xb_add(&bar[XB_XSUB(b.x)], 1u);
        const unsigned gen = old / nloc;
        if (old + 1u == (gen + 1u) * nloc) {
            __builtin_amdgcn_fence(__ATOMIC_RELEASE, "agent");
            asm volatile("s_waitcnt vmcnt(0)" ::: "memory");
            const unsigned og = xb_add(&bar[XB_TOP], 1u);
            const unsigned tg = og / nx;
            if (og + 1u == (tg + 1u) * nx) xb_add(&bar[XB_TOPGEN], 1u);
            else XB_SPIN(xb_ld(&bar[XB_TOPGEN]) == tg, bar);
            __builtin_amdgcn_fence(__ATOMIC_ACQUIRE, "agent");
            xb_add(&bar[XB_XGEN(b.x)], 1u);
            asm volatile("s_waitcnt vmcnt(0)" ::: "memory");
        } else {
            XB_SPIN(xb_ld(&bar[XB_XGEN(b.x)]) == gen, bar);
            __builtin_amdgcn_fence(__ATOMIC_ACQUIRE, "agent");
            asm volatile("s_waitcnt vmcnt(0)" ::: "memory");
        }
    }
    __syncthreads();
}

struct GemmDesc { const bf16_t* A; int lda; const void* Bt; int M, N, K; pg8::EpiAny E; int crot; };
DI GemmDesc get_gemm(const Ctx& C, const Args& a, int s, int gi) {
    unsigned char* wl = C.wl(); float* hres = a.out; GemmDesc d; d.crot = 0;
    d.E.mode = 0; d.E.O = nullptr; d.E.ldc = 0; d.E.ncols = 0; d.E.base = nullptr; d.E.out = nullptr; d.E.alpha = 0.f;
    if (s == 0 || s == 10) { d.A = C.XN(); d.lda = DM; d.Bt = wl + (s == 0 ? W_GU1 : W_GU2); d.M = NTOK; d.N = 2 * DFF; d.K = DM; d.E.mode = 1; d.E.O = C.HID(); d.E.ldc = DFF; }
    else if (s == 1 || s == 11) { d.A = C.HID(); d.lda = DFF; d.Bt = wl + (s == 1 ? W_D1 : W_D2); d.M = NTOK; d.N = DM; d.K = DFF; d.E.mode = 2;
        d.E.base = (s == 1 && C.layer == 0) ? a.in[0] : hres; d.E.out = hres; d.E.ldc = DM; d.E.alpha = 0.5f; }
    else if (s == 3) { d.A = C.XN(); d.lda = DM; d.Bt = wl + W_IN; d.M = NTOK; d.N = 5120; d.K = DM; d.E.O = C.U(); d.E.ldc = NU; d.E.ncols = 5120; }
    else if (s == 8) { d.A = C.MIX(); d.lda = DM; d.Bt = wl + W_OUT; d.M = NTOK; d.N = DM; d.K = DM; d.E.mode = 2; d.E.base = hres; d.E.out = hres; d.E.ldc = DM; d.E.alpha = 1.0f; }
    else if (gi == 0) { d.A = C.U() + U_CQ; d.lda = NU; d.Bt = wl + W_UQ; d.M = NTOK; d.N = 768; d.K = 512; d.E.O = C.QM(); d.E.ldc = 768; d.E.ncols = 768; }
    else if (gi == 1) { d.A = C.U() + U_CKV; d.lda = NU; d.Bt = wl + W_UKV; d.M = NTOK; d.N = 1024; d.K = 256; d.E.O = C.KVR(); d.E.ldc = 1024; d.E.ncols = 1024; }
    else if (gi == 2) { d.A = C.AK(); d.lda = 4096; d.Bt = wl + W_CK; d.M = 1024; d.N = 256; d.K = 4096; d.E.O = C.KC(); d.E.ldc = 128; d.E.ncols = 128; d.crot = 192; }
    else if (gi == 4) { d.A = C.XN(); d.lda = DM; d.Bt = (const bf16_t*)(wl + W_IN) + (size_t)5120 * DM; d.M = NTOK; d.N = 256; d.K = DM; d.E.O = C.U() + 5120; d.E.ldc = NU; d.E.ncols = 256; d.crot = 128; }
    else { d.A = C.AV(); d.lda = 4096; d.Bt = wl + W_CV; d.M = 1024; d.N = 256; d.K = 4096; d.E.O = C.VCR(); d.E.ldc = 128; d.E.ncols = 128; d.crot = 200; }
    return d;
}
__global__ void __launch_bounds__(512, 2) mega_fwd(Args a) {
    extern __shared__ __attribute__((aligned(16))) unsigned char lds_raw[];
    LAS unsigned char* lds = (LAS unsigned char*)lds_raw;
    cg::grid_group grid = cg::this_grid();
    const int NSTEP = 13 * NLAYER;
    volatile LAS unsigned* MISC = (volatile LAS unsigned*)(lds + 131072 + 320);
    if (threadIdx.x < 32) MISC[threadIdx.x] = 0u;
    __syncthreads();
#pragma unroll 1
    for (int step = 0; step < NSTEP; ++step) {
#if PROBE_SPIN
        unsigned long long pt0s = __builtin_amdgcn_s_memrealtime();
#endif
        if (step >= a.ph_lo && step < a.ph_hi) {
#if PROBE_SPIN
            const unsigned long long pt0 = __builtin_amdgcn_s_memrealtime();
#endif
            const int tid = otid(), lane = tid & 63, wave = __builtin_amdgcn_readfirstlane(tid >> 6);
            const int G = gridDim.x, c = blockIdx.x, gw = c * 8 + wave, NGW = G * 8;
            if (step == 0) {
                { const XcdBarrier b0 = xcd_barrier_post((unsigned*)(a.ws + WS_CTL) + 1024, MISC + 8); if (threadIdx.x == 0) MISC[10] = b0.x; }
#ifndef NO_P0
                for (int rep = 0; rep < (PROBE_DOUBLE == 3 ? 2 : 1); ++rep) p0_weights(a, lds, gw, NGW, wave, lane);
                norm_rows(a.in[0], (bf16_t*)(a.ws + WS_XN), gw, NGW, lane);
#endif
            }
            else {
                const int L = (step - 1) / 13, s = (step - 1) - 13 * L; const Ctx C = make_ctx(a, L);
                const int ng = (s == 0 || s == 1 || s == 3 || s == 8 || s == 10 || s == 11) ? 1 : (s == 5 ? 5 : 0);
                if (ng) {
#pragma unroll 1
                    for (int gi0 = 0; gi0 < ng * ((PROBE_DOUBLE == 2 && (s == 0 || s == 10)) ? 2 : 1); ++gi0) { const int gi = gi0 % ng; const GemmDesc d = get_gemm(C, a, s, gi);
                        pg8::Gemm g{d.A, (const bf16_t*)d.Bt, d.M, d.N, d.K, d.lda}; pg8::StaticOrder S; S.init(d.M, d.N, G, (c + G - (d.crot % G)) % G);
                        pg8::gemm_phase<pg8::EpiAny, pg8::StaticOrder, true, true>(lds, g, S, d.E); }
                }
#ifndef NO_NORM
                else if (s == 2 || s == 9 || s == 12) norm_rows(a.out, C.XN(), gw, NGW, lane);
#endif
#ifndef NO_FIX
                else if (s == 4) fix1(C, gw, NGW, lane);
                else if (s == 6) fix2(C, gw, NGW, lane);
#endif
                else if (s == 7) { att::attn_phase(lds, C, (unsigned*)(a.ws + WS_CTL) + 64 + 64 * L);
#if PROBE_DOUBLE == 1
                    att::attn_phase(lds, C, (unsigned*)(a.ws + WS_CTL) + 256 + 64 * L);
#endif
                }
            }
        }
#if PROBE_SPIN
        {
            int cls; if (step == 0) cls = 1; else { const int s = (step - 1) % 13; cls = (s == 0 || s == 1 || s == 3 || s == 8 || s == 10 || s == 11) ? 2 : (s == 2 || s == 9 || s == 12) ? 4 : (s == 4 || s == 6) ? 8 : (s == 5) ? 16 : 32; }
            if (cls & PROBE_SPIN) { const unsigned long long pt1 = __builtin_amdgcn_s_memrealtime(); const unsigned long long dt = pt1 - pt0s;
                while (__builtin_amdgcn_s_memrealtime() - pt1 < dt) __builtin_amdgcn_s_sleep(8); }
        }
#endif
        if (step >= a.ph_lo && step + 1 < a.ph_hi && step + 1 < NSTEP) { if (step == 0) grid.sync(); else { XcdBarrier bar; bar.bar = (unsigned*)(a.ws + WS_CTL) + 1024; bar.st = MISC + 8; bar.x = MISC[10]; xcd_barrier(bar);
#if PROBE_SEAM
            xcd_barrier(bar); xcd_barrier(bar);
#endif
            } }
    }
}

extern "C" void kernel_launch(void* const* d_in, const int* in_sizes, int n_in, void* d_out, int out_size, void* d_ws, size_t ws_size, hipStream_t stream) {
    static int grid = 0;
    if (grid == 0) {
        if (n_in != 38 || out_size != NTOK * DM || ws_size < WS_END) { fprintf(stderr, "kernel_launch: unexpected shapes (n_in %d, out %d, ws %zu, need %zu)\n", n_in, out_size, ws_size, (size_t)WS_END); grid = -1; return; }
        int dev = 0, cus = 0, per_cu = 0;
        if (hipGetDevice(&dev) != hipSuccess || hipDeviceGetAttribute(&cus, hipDeviceAttributeMultiprocessorCount, dev) != hipSuccess) { grid = -1; return; }
        if (hipFuncSetAttribute((const void*)mega_fwd, hipFuncAttributeMaxDynamicSharedMemorySize, LDS_BYTES) != hipSuccess) { fprintf(stderr, "kernel_launch: hipFuncSetAttribute failed\n"); grid = -1; return; }
        if (hipOccupancyMaxActiveBlocksPerMultiprocessor(&per_cu, (const void*)mega_fwd, 512, LDS_BYTES) != hipSuccess || per_cu < 1) { fprintf(stderr, "kernel_launch: occupancy query says %d\n", per_cu); (void)hipGetLastError(); }
        grid = cus;
    }
    if (grid < 0) return;
    (void)hipMemsetAsync((char*)d_ws + WS_CTL, 0, 32768, stream);
    Args a{};
    for (int i = 0; i < 38; ++i) a.in[i] = (const float*)d_in[i];
    a.out = (float*)d_out; a.ws = (unsigned char*)d_ws;
    for (int i = 0; i < 32; ++i) a.inv_freq[i] = (float)pow(10000.0, -(double)(2 * i) / 64.0);
    a.ph_lo = 0; a.ph_hi = 1 << 20;
    void* args[] = {&a};
    hipError_t e = hipLaunchCooperativeKernel((const void*)mega_fwd, dim3(grid), dim3(512), args, LDS_BYTES, stream);
    if (e != hipSuccess) fprintf(stderr, "kernel_launch: cooperative launch failed: %s (grid %d)\n", hipGetErrorString(e), grid);
}
```

```cpp
#include <hip/hip_runtime.h>
#include <hip/hip_cooperative_groups.h>
#include <cstdio>
#include <cstdint>
#include <cmath>
namespace cg = cooperative_groups;
namespace pg8 {
#define PG8_LAS __attribute__((address_space(3)))
typedef unsigned short bf16_t;
typedef short bf16x8 __attribute__((ext_vector_type(8)));
typedef float f32x4 __attribute__((ext_vector_type(4)));
typedef unsigned u32x4 __attribute__((ext_vector_type(4)));
constexpr int BM = 256, BK = 64, HALF = 128, HTB = HALF * BK * 2  , STAGE_BYTES = 8 * HTB, NXCD = 8, WGM = 8;

__host__ __device__ __forceinline__ int lds_byte(int r, int c) { const int st = (r >> 4) * 2 + (c >> 5), rr = r & 15, cc = c & 31, ob = rr * 64 + cc * 2; return st * 1024 + (ob ^ (((ob >> 9) & 1) << 5)); }
__host__ __device__ __forceinline__ void stage_rc(int b, int& R, int& C) { const int st = b / 1024, sb = b % 1024, swz = sb ^ (((sb >> 9) & 1) << 5); R = (st >> 1) * 16 + swz / 64; C = (st & 1) * 32 + (swz % 64) / 2; }
__host__ __device__ __forceinline__ int perm32(int rho) { const int n = rho >> 4, i = rho & 15; return 8 * (i >> 2) + 4 * n + (i & 3); }

struct Unit { int pm, pn; };
struct Gemm { const bf16_t* A; const bf16_t* Bt; int M, N, K, lda; };

struct StaticOrder {
    int nM, nN, nwg, G, c;
    __host__ __device__ void init(int M, int N, int G_, int c_) { nM = M / BM; nN = N / BM; nwg = nM * nN; G = G_; c = c_; }
    __host__ __device__ bool next(int i, Unit& u) const {
        const long L = (long)i * G + c; if (L >= nwg) return false;
        int wgid = (int)L; { const int q = nwg / NXCD, r = nwg % NXCD, xcd = wgid % NXCD, off = wgid / NXCD; wgid = (xcd < r ? xcd * (q + 1) : r * (q + 1) + (xcd - r) * q) + off; }
        const int nig = WGM * nN, gid = wgid / nig, fm = gid * WGM, gsz = (nM - fm) < WGM ? (nM - fm) : WGM;
        u.pm = fm + ((wgid % nig) % gsz); u.pn = (wgid % nig) / gsz; return true;
    }
    __device__ __forceinline__ void a_ready(const Unit&) const {}
    __device__ __forceinline__ void done(const Unit&) const {}
};

__device__ __forceinline__ unsigned cvt_pk_bf16(float lo, float hi) { unsigned r; asm volatile("v_cvt_pk_bf16_f32 %0, %1, %2" : "=v"(r) : "v"(lo), "v"(hi)); return r; }
typedef float f32x2 __attribute__((ext_vector_type(2)));
struct EpiStoreBf16 {
    static constexpr bool PERM = true, AFTER_DRAIN = false;
    bf16_t* O; int ldc; int ncols;
    __device__ __forceinline__ void operator()(const f32x4 (&acc)[2][2][4][2], const Unit& u, int wr, int wc, int fr, int fq) const {
        const int row0 = u.pm * BM + wr * 64 + fr; const int col0 = u.pn * BM + wc * 32 + 8 * fq;
#pragma unroll
        for (int ai = 0; ai < 2; ++ai)
#pragma unroll
            for (int m = 0; m < 4; ++m) { bf16_t* rowp = O + (size_t)(row0 + ai * HALF + m * 16) * ldc;
#pragma unroll
                for (int bj = 0; bj < 2; ++bj) { const int c = col0 + bj * HALF;
                    if (c < ncols) { const f32x4 v0 = acc[ai][bj][m][0], v1 = acc[ai][bj][m][1]; u32x4 w;
                        w.x = cvt_pk_bf16(v0[0], v0[1]); w.y = cvt_pk_bf16(v0[2], v0[3]); w.z = cvt_pk_bf16(v1[0], v1[1]); w.w = cvt_pk_bf16(v1[2], v1[3]);
                        *(u32x4*)(rowp + c) = w; } } }
    }
};
struct EpiSwiGLU {
    static constexpr bool PERM = true, AFTER_DRAIN = false;
    bf16_t* H; int ldc;
    __device__ __forceinline__ void operator()(const f32x4 (&acc)[2][2][4][2], const Unit& u, int wr, int wc, int fr, int fq) const {
        const int row0 = u.pm * BM + wr * 64 + fr; const int col0 = u.pn * HALF + wc * 32 + 8 * fq;
#pragma unroll
        for (int ai = 0; ai < 2; ++ai)
#pragma unroll
            for (int m = 0; m < 4; ++m) { bf16_t* rowp = H + (size_t)(row0 + ai * HALF + m * 16) * ldc + col0;
                float r[8];
#pragma unroll
                for (int n = 0; n < 2; ++n)
#pragma unroll
                    for (int e = 0; e < 4; ++e) { const float g = acc[ai][0][m][n][e], up = acc[ai][1][m][n][e];
                        r[n * 4 + e] = g * up * __builtin_amdgcn_rcpf(1.0f + __builtin_amdgcn_exp2f(g)); }
                u32x4 w; w.x = cvt_pk_bf16(r[0], r[1]); w.y = cvt_pk_bf16(r[2], r[3]); w.z = cvt_pk_bf16(r[4], r[5]); w.w = cvt_pk_bf16(r[6], r[7]);
                *(u32x4*)rowp = w; }
    }
};
struct EpiResid {
    static constexpr bool PERM = false, AFTER_DRAIN = false;
    const float* base; float* out; int ldc; float alpha;
    __device__ __forceinline__ void operator()(const f32x4 (&acc)[2][2][4][2], const Unit& u, int wr, int wc, int fr, int fq) const {
        const int row0 = u.pm * BM + wr * 64 + fr; const int col0 = u.pn * BM + wc * 32 + 4 * fq;
#pragma unroll
        for (int ai = 0; ai < 2; ++ai) {
            f32x4 b[4][2][2];
#pragma unroll
            for (int m = 0; m < 4; ++m) { const size_t off = (size_t)(row0 + ai * HALF + m * 16) * ldc + col0;
#pragma unroll
                for (int bj = 0; bj < 2; ++bj)
#pragma unroll
                    for (int n = 0; n < 2; ++n) b[m][bj][n] = *(const f32x4*)(base + off + bj * HALF + n * 16); }
#pragma unroll
            for (int m = 0; m < 4; ++m) { const size_t off = (size_t)(row0 + ai * HALF + m * 16) * ldc + col0;
#pragma unroll
                for (int bj = 0; bj < 2; ++bj)
#pragma unroll
                    for (int n = 0; n < 2; ++n) *(f32x4*)(out + off + bj * HALF + n * 16) = b[m][bj][n] + acc[ai][bj][m][n] * alpha; }
            asm volatile("" ::: "memory");
        }
    }
};
struct EpiAny {
    static constexpr bool AFTER_DRAIN = false;
    int mode; bf16_t* O; int ldc; int ncols; const float* base; float* out; float alpha;
    __device__ __forceinline__ bool perm() const { return mode != 2; }
    __device__ __forceinline__ void operator()(const f32x4 (&acc)[2][2][4][2], const Unit& u, int wr, int wc, int fr, int fq) const {
#ifndef NO_E0
        if (mode == 0) { EpiStoreBf16 e{O, ldc, ncols}; e(acc, u, wr, wc, fr, fq); }
#endif
#ifndef NO_E1
        if (mode == 1) { EpiSwiGLU e{O, ldc}; e(acc, u, wr, wc, fr, fq); }
#endif
#ifndef NO_E2
        if (mode == 2) { EpiResid e{base, out, ldc, alpha}; e(acc, u, wr, wc, fr, fq); }
#endif
    }
};
template <class Epi, class Sched, bool ALIGN_EPI = false, bool SP2 = false>
__device__ __forceinline__ void gemm_phase(PG8_LAS unsigned char* lds, const Gemm g, const Sched& S, const Epi& E) {
    int tid = threadIdx.x; asm volatile("" : "+v"(tid)); const int wid = __builtin_amdgcn_readfirstlane(tid >> 6), lane = tid & 63, wr = wid >> 2, wc = wid & 3, fr = lane & 15, fq = lane >> 4;
    const int K = g.K, nt = K / BK;
    unsigned voffA[2], voffB[2];
#pragma unroll
    for (int i = 0; i < 2; ++i) { int R, C; stage_rc(tid * 16 + i * 8192, R, C); const int Rb = E.perm() ? ((R & ~31) + perm32(R & 31)) : R;
        voffA[i] = (unsigned)(R * g.lda + C) * 2u; voffB[i] = (unsigned)(Rb * K + C) * 2u; }
    const size_t kstep = (size_t)(BK * 2);
    const size_t hstep = (size_t)HALF * K * 2;
    const size_t tstep = 2 * hstep; const size_t hstepA = (size_t)HALF * g.lda * 2, tstepA = 2 * hstepA;
    const unsigned ldsw = (unsigned)wid * 1024u;
    const int aoff = lds_byte(wr * 64 + fr, fq * 8), boff = lds_byte(wc * 32 + fr, fq * 8);
#define PG8_SA(b, h) (((b) * 2 + (h)) * HTB)
#define PG8_SB(b, h) ((4 + (b) * 2 + (h)) * HTB)
#define PG8_STAGE(bufoff, gbase, voff) do { _Pragma("unroll") for (int _i = 0; _i < 2; ++_i) \
        __builtin_amdgcn_global_load_lds((const unsigned*)((const char*)(gbase) + (voff)[_i]), (PG8_LAS unsigned*)(lds + (bufoff) + ldsw + _i * 8192), 16, 0, 0); } while (0)
#define PG8_LDA(dst, b, h) do { _Pragma("unroll") for (int m = 0; m < 4; ++m) _Pragma("unroll") for (int k = 0; k < 2; ++k) dst[m][k] = *(const PG8_LAS bf16x8*)(lds + PG8_SA(b, h) + aoff + m * 2048 + k * 1024); } while (0)
#define PG8_LDB(dst, b, h) do { _Pragma("unroll") for (int n = 0; n < 2; ++n) _Pragma("unroll") for (int k = 0; k < 2; ++k) dst[n][k] = *(const PG8_LAS bf16x8*)(lds + PG8_SB(b, h) + boff + n * 2048 + k * 1024); } while (0)
#define PG8_MMA(ai, bj, At, Bt) do { __builtin_amdgcn_s_setprio(1); _Pragma("unroll") for (int m = 0; m < 4; ++m) _Pragma("unroll") for (int n = 0; n < 2; ++n) _Pragma("unroll") for (int k = 0; k < 2; ++k) \
        acc[ai][bj][m][n] = __builtin_amdgcn_mfma_f32_16x16x32_bf16(Bt[n][k], At[m][k], acc[ai][bj][m][n], 0, 0, 0); __builtin_amdgcn_s_setprio(0); } while (0)
#define PG8_WAIT_V(n) asm volatile("s_waitcnt vmcnt(" #n ")" ::: "memory")
#define PG8_WAIT_L(n) asm volatile("s_waitcnt lgkmcnt(" #n ")" ::: "memory")
#define PG8_BAR __builtin_amdgcn_s_barrier()
#define PG8_SCHED __builtin_amdgcn_sched_barrier(0)
    Unit cur, nxt; int ui = 0;
    if (!S.next(0, cur)) return;
    f32x4 acc[2][2][4][2];
#pragma unroll
    for (int a = 0; a < 2; ++a)
#pragma unroll
        for (int b = 0; b < 2; ++b)
#pragma unroll
            for (int m = 0; m < 4; ++m)
#pragma unroll
                for (int n = 0; n < 2; ++n) acc[a][b][m][n] = (f32x4){0.f, 0.f, 0.f, 0.f};
    bf16x8 At[4][2], B0[2][2], B1[2][2];
    const char* cA = (const char*)g.A + (size_t)cur.pm * tstepA; const char* cB = (const char*)g.Bt + (size_t)cur.pn * tstep;
    S.a_ready(cur);
    if constexpr (SP2) {
        PG8_STAGE(PG8_SB(0, 0), cB, voffB); PG8_STAGE(PG8_SB(0, 1), cB + hstep, voffB); PG8_STAGE(PG8_SA(0, 0), cA, voffA); PG8_STAGE(PG8_SA(0, 1), cA + hstepA, voffA);
        if (wr == 1) PG8_BAR;
        PG8_WAIT_V(2); PG8_BAR;
        PG8_STAGE(PG8_SB(1, 0), cB + kstep, voffB); PG8_STAGE(PG8_SA(1, 0), cA + kstep, voffA); PG8_STAGE(PG8_SB(1, 1), cB + hstep + kstep, voffB);
        PG8_WAIT_V(6); PG8_BAR;
    } else {
        PG8_STAGE(PG8_SB(0, 0), cB, voffB); PG8_STAGE(PG8_SA(0, 0), cA, voffA); PG8_STAGE(PG8_SB(0, 1), cB + hstep, voffB); PG8_STAGE(PG8_SA(0, 1), cA + hstepA, voffA);
        if (wr == 1) PG8_BAR;
        PG8_WAIT_V(4); PG8_BAR;
        PG8_STAGE(PG8_SB(1, 0), cB + kstep, voffB); PG8_STAGE(PG8_SA(1, 0), cA + kstep, voffA); PG8_STAGE(PG8_SB(1, 1), cB + hstep + kstep, voffB);
        PG8_WAIT_V(6); PG8_BAR;
    }
    for (;;) {
        const bool has_next = S.next(ui + 1, nxt);
        const char* nA = has_next ? (const char*)g.A + (size_t)nxt.pm * tstepA : cA; const char* nB = has_next ? (const char*)g.Bt + (size_t)nxt.pn * tstep : cB;
        for (int t = 0; t < nt; t += 2) {
            const bool last = (t == nt - 2);
            const char* a1 = cA + (size_t)(t + 1) * kstep;
            const char* a2 = last ? nA : cA + (size_t)(t + 2) * kstep; const char* b2 = last ? nB : cB + (size_t)(t + 2) * kstep;
            const char* a3 = a2 + kstep; const char* b3 = b2 + kstep;
            if (last && has_next) S.a_ready(nxt);
            if constexpr (SP2) {
            PG8_LDB(B0, 0, 0); PG8_LDB(B1, 0, 1); PG8_SCHED; PG8_LDA(At, 0, 0); PG8_STAGE(PG8_SA(1, 1), a1 + hstepA, voffA);
            PG8_WAIT_V(8); PG8_WAIT_L(0); PG8_BAR; PG8_MMA(0, 0, At, B0); PG8_MMA(0, 1, At, B1); PG8_BAR; PG8_SCHED;
            PG8_LDA(At, 0, 1); PG8_STAGE(PG8_SB(0, 0), b2, voffB); PG8_STAGE(PG8_SB(0, 1), b2 + hstep, voffB); PG8_STAGE(PG8_SA(0, 0), a2, voffA);
            PG8_WAIT_V(8); PG8_WAIT_L(0); PG8_BAR; PG8_MMA(1, 0, At, B0); PG8_MMA(1, 1, At, B1); PG8_BAR; PG8_SCHED;
            PG8_LDB(B0, 1, 0); PG8_LDB(B1, 1, 1); PG8_SCHED; PG8_LDA(At, 1, 0); PG8_STAGE(PG8_SA(0, 1), a2 + hstepA, voffA);
            PG8_WAIT_V(8); PG8_WAIT_L(0); PG8_BAR; PG8_MMA(0, 0, At, B0); PG8_MMA(0, 1, At, B1); PG8_BAR; PG8_SCHED;
            PG8_LDA(At, 1, 1); PG8_STAGE(PG8_SB(1, 0), b3, voffB); PG8_STAGE(PG8_SB(1, 1), b3 + hstep, voffB); PG8_STAGE(PG8_SA(1, 0), a3, voffA);
            PG8_WAIT_V(8); PG8_WAIT_L(0); PG8_BAR; PG8_MMA(1, 0, At, B0); PG8_MMA(1, 1, At, B1); PG8_BAR; PG8_SCHED;
            } else {
            PG8_LDB(B0, 0, 0); PG8_SCHED; PG8_LDA(At, 0, 0); PG8_STAGE(PG8_SA(1, 1), a1 + hstepA, voffA);
            PG8_WAIT_L(8); PG8_BAR; PG8_WAIT_L(0); PG8_MMA(0, 0, At, B0); PG8_BAR; PG8_SCHED;
            PG8_LDB(B1, 0, 1); PG8_STAGE(PG8_SB(0, 0), b2, voffB);
            PG8_BAR; PG8_WAIT_L(0); PG8_MMA(0, 1, At, B1); PG8_BAR;
            PG8_LDA(At, 0, 1); PG8_STAGE(PG8_SA(0, 0), a2, voffA);
            PG8_BAR; PG8_WAIT_L(0); PG8_MMA(1, 0, At, B0); PG8_BAR; PG8_SCHED;
            PG8_STAGE(PG8_SB(0, 1), b2 + hstep, voffB);
            PG8_WAIT_V(6); PG8_BAR; PG8_MMA(1, 1, At, B1); PG8_BAR;
            PG8_LDB(B0, 1, 0); PG8_SCHED; PG8_LDA(At, 1, 0); PG8_STAGE(PG8_SA(0, 1), a2 + hstepA, voffA);
            PG8_WAIT_L(8); PG8_BAR; PG8_WAIT_L(0); PG8_MMA(0, 0, At, B0); PG8_BAR; PG8_SCHED;
            PG8_LDB(B1, 1, 1); PG8_STAGE(PG8_SB(1, 0), b3, voffB);
            PG8_BAR; PG8_WAIT_L(0); PG8_MMA(0, 1, At, B1); PG8_BAR;
            PG8_LDA(At, 1, 1); PG8_STAGE(PG8_SA(1, 0), a3, voffA);
            PG8_BAR; PG8_WAIT_L(0); PG8_MMA(1, 0, At, B0); PG8_BAR; PG8_SCHED;
            PG8_STAGE(PG8_SB(1, 1), b3 + hstep, voffB);
            PG8_WAIT_V(6); PG8_BAR; PG8_MMA(1, 1, At, B1); PG8_BAR;
            }
        }
        if constexpr (ALIGN_EPI) { if (wr == 0) PG8_BAR; }
        if constexpr (!Epi::AFTER_DRAIN) { E(acc, cur, wr, wc, fr, fq); S.done(cur); }
        if (!has_next) break;
#pragma unroll
        for (int a = 0; a < 2; ++a)
#pragma unroll
            for (int b = 0; b < 2; ++b)
#pragma unroll
                for (int m = 0; m < 4; ++m)
#pragma unroll
                    for (int n = 0; n < 2; ++n) acc[a][b][m][n] = (f32x4){0.f, 0.f, 0.f, 0.f};
        cur = nxt; cA = nA; cB = nB; ++ui;
        if constexpr (ALIGN_EPI) { if (wr == 1) PG8_BAR; }
    }
    PG8_WAIT_V(0);
    if constexpr (!ALIGN_EPI) { if (wr == 0) PG8_BAR; }
    PG8_BAR;
    if constexpr (Epi::AFTER_DRAIN) { E.fused(acc, cur, wr, wc, fr, fq, lds, wid, lane); S.done(cur); }
#undef PG8_SA
#undef PG8_SB
#undef PG8_STAGE
#undef PG8_LDA
#undef PG8_LDB
#undef PG8_MMA
#undef PG8_WAIT_V
#undef PG8_WAIT_L
#undef PG8_BAR
#undef PG8_SCHED
}
}

#define DI __device__ __forceinline__
#define LAS __attribute__((address_space(3)))
typedef unsigned short bf16_t;
typedef short bf16x8 __attribute__((ext_vector_type(8)));
typedef short s16x4 __attribute__((ext_vector_type(4)));
typedef float f32x4 __attribute__((ext_vector_type(4)));
typedef float f32x16 __attribute__((ext_vector_type(16)));
typedef unsigned u32x4 __attribute__((ext_vector_type(4)));
typedef unsigned u32x2 __attribute__((ext_vector_type(2)));

constexpr int NTOK = 16384, SEQ = 4096, DM = 2048, DFF = 5632, NU = 5376  , NLAYER = 2;
constexpr float EPS = 1e-6f, LOG2E = 1.4426950408889634f;
constexpr int U_CQ = 0, U_CKV = 512, U_KR = 768, U_DQ = 832, U_DK = 1344, U_DV = 1856, U_NQ = 2368, U_KC = 2880, U_VC = 3008, U_KS = 3136, U_VS = 3264,
              U_KW = 3392, U_VW = 3520, U_SQ = 3648, U_SK = 4160, U_SV = 4672, U_G = 5184;
constexpr size_t MiB = 1u << 20;
constexpr size_t W_GU1 = 0, W_D1 = 44 * MiB, W_IN = 66 * MiB, W_UQ = 87 * MiB, W_UKV = 88 * MiB, W_CK = 89 * MiB, W_CV = 90 * MiB, W_OUT = 92 * MiB, W_GU2 = 100 * MiB,
                 W_D2 = 144 * MiB, W_LAYER = 166 * MiB;
constexpr size_t WS_CTL = 0, WS_W = 1 * MiB, WS_XN = WS_W + 2 * W_LAYER  , WS_HID = WS_XN + 64 * MiB  ,
                 WS_QM = WS_HID + 176 * MiB  , WS_KM = WS_QM + 24 * MiB, WS_KVR = WS_KM + 24 * MiB, WS_VTM = WS_KVR + 32 * MiB, WS_VTD = WS_VTM + 16 * MiB,
                 WS_VTS = WS_VTD + 16 * MiB, WS_VTVS = WS_VTS + 16 * MiB, WS_VTVW = WS_VTVS + 4 * MiB, WS_AK = WS_VTVW + 4 * MiB, WS_AV = WS_AK + 8 * MiB,
                 WS_KC = WS_AV + 9 * MiB, WS_VCR = WS_KC + 1 * MiB, WS_VTVC = WS_VCR + 1 * MiB, WS_STASH = WS_VTVC + 1 * MiB  , WS_END = WS_STASH + 32 * MiB;
static_assert(WS_END <= 762 * MiB, "workspace map");

DI float bf2f(unsigned b) { return __uint_as_float(b << 16); }
typedef float f32x2_t __attribute__((ext_vector_type(2))); typedef __bf16 bf16x2_t __attribute__((ext_vector_type(2)));
DI unsigned pk2(float lo, float hi) { f32x2_t v = {lo, hi}; bf16x2_t b = __builtin_convertvector(v, bf16x2_t); return __builtin_bit_cast(unsigned, b); }
DI float wave_sum(float v) {
#pragma unroll
    for (int o = 1; o < 64; o <<= 1) v += __shfl_xor(v, o);
    return v; }
template <int W> DI float grp_sum(float v) {
#pragma unroll
    for (int o = 1; o < W; o <<= 1) v += __shfl_xor(v, o);
    return v; }
DI void ld8(const bf16_t* p, float (&f)[8]) { const u32x4 v = *(const u32x4*)p;
    f[0] = bf2f(v.x & 0xffffu); f[1] = bf2f(v.x >> 16); f[2] = bf2f(v.y & 0xffffu); f[3] = bf2f(v.y >> 16);
    f[4] = bf2f(v.z & 0xffffu); f[5] = bf2f(v.z >> 16); f[6] = bf2f(v.w & 0xffffu); f[7] = bf2f(v.w >> 16); }
DI void st8(bf16_t* p, const float (&f)[8]) { u32x4 w; w.x = pk2(f[0], f[1]); w.y = pk2(f[2], f[3]); w.z = pk2(f[4], f[5]); w.w = pk2(f[6], f[7]); *(u32x4*)p = w; }
DI float ssq8(const float (&f)[8]) { float s = 0.f;
#pragma unroll
    for (int e = 0; e < 8; ++e) s += f[e] * f[e];
    return s; }
DI int otid() { int t = (int)threadIdx.x; asm volatile("" : "+v"(t)); return t; }
#define LDS_WAIT() asm volatile("s_waitcnt lgkmcnt(0)" ::: "memory")

struct Args { const float* in[38]; float* out; unsigned char* ws; float inv_freq[32]; int ph_lo, ph_hi; };

struct Ctx {
    int layer; const Args* a; unsigned char* ws;
    DI unsigned char* wl() const { return ws + WS_W + (size_t)layer * W_LAYER; }
#define CTX_PTR(name, off) DI bf16_t* name() const { return (bf16_t*)(ws + (off)); }
    CTX_PTR(XN, WS_XN) CTX_PTR(MIX, WS_XN) CTX_PTR(HID, WS_HID) CTX_PTR(U, WS_HID) CTX_PTR(QM, WS_QM) CTX_PTR(KM, WS_KM) CTX_PTR(KVR, WS_KVR) CTX_PTR(VTM, WS_VTM)
    CTX_PTR(VTD, WS_VTD) CTX_PTR(VTS, WS_VTS) CTX_PTR(VTVS, WS_VTVS) CTX_PTR(VTVW, WS_VTVW) CTX_PTR(AK, WS_AK) CTX_PTR(AV, WS_AV) CTX_PTR(KC, WS_KC) CTX_PTR(VCR, WS_VCR)
    CTX_PTR(VTVC, WS_VTVC)
#undef CTX_PTR
};
DI Ctx make_ctx(const Args& a, int layer) { Ctx c; c.layer = layer; c.a = &a; c.ws = a.ws; return c; }

struct WDesc { const float* W; const float* gain; bf16_t* WT; int K, N, mode; float cscale; };
DI int wt_out_row(int mode, int c) {
    if (mode == 1) return 256 * (c >> 7) + (c & 127);
    if (mode == 2) return 256 * (c >> 7) + 128 + (c & 127);
    if (mode == 3) return c < 3648 ? c : (c < 3660 ? U_G + (c - 3648) : c - 12);
    return c;
}
DI void wt_item(const WDesc& d, LAS unsigned* scr, int item, int lane) {
    const int nblk = (d.N + 63) >> 6, kb = item / nblk, nb = item - kb * nblk, k0 = 64 * kb, n0 = 64 * nb;
    const int c = n0 + lane; const bool cv = c < d.N;
    float cs = 1.f; if (d.mode == 3 && c >= 3660 && c < 4172) cs = d.cscale; if (d.mode == 1 || d.mode == 2) cs = d.cscale;
    float wv[64];
    const float* wp = d.W + (size_t)k0 * d.N + (cv ? c : 0);
#pragma unroll
    for (int i = 0; i < 64; ++i) wv[i] = wp[(size_t)i * d.N];
#pragma unroll
    for (int jp = 0; jp < 32; ++jp) { float w0 = cv ? wv[2 * jp] : 0.f, w1 = cv ? wv[2 * jp + 1] : 0.f;
        if (d.gain) { w0 *= d.gain[k0 + 2 * jp]; w1 *= d.gain[k0 + 2 * jp + 1]; }
        scr[jp * 65 + lane] = pk2(w0 * cs, w1 * cs); }
    LDS_WAIT();
    const int ch = lane & 7, nl = lane >> 3;
#pragma unroll
    for (int jn = 0; jn < 8; ++jn) { const int n = nl + 8 * jn; const int cc = n0 + n;
        if (cc < d.N) { const LAS unsigned* sp = scr + (4 * ch) * 65 + n; u32x4 o; o.x = sp[0]; o.y = sp[65]; o.z = sp[130]; o.w = sp[195];
            *(u32x4*)(d.WT + (size_t)wt_out_row(d.mode, cc) * d.K + k0 + 8 * ch) = o; } }
    LDS_WAIT();
}
constexpr int WI_G = 32 * 88, WI_D = 88 * 32, WI_IN = 32 * 82, WI_UQ = 8 * 12, WI_UKV = 4 * 16, WI_C = 64 * 2, WI_OUT = 32 * 32;
constexpr int WI_LAYER = 6 * WI_G + WI_IN + WI_UQ + WI_UKV + 2 * WI_C + WI_OUT;
DI void p0_weights(const Args& a, LAS unsigned char* lds, int gw, int NGW, int wave, int lane) {
    LAS unsigned* scr = (LAS unsigned*)(lds + wave * 8704);
    for (int it = gw; it < NLAYER * WI_LAYER; it += NGW) {
        const int L = it / WI_LAYER; int r = it - L * WI_LAYER; unsigned char* wl = a.ws + WS_W + (size_t)L * W_LAYER;
        const size_t oDF = (size_t)L * DM * DFF, oD = (size_t)L * DM; WDesc d; d.cscale = 1.f; d.gain = nullptr;
        if (r < WI_G) { d = WDesc{a.in[2] + oDF, a.in[1] + oD, (bf16_t*)(wl + W_GU1), DM, DFF, 1, -LOG2E}; }
        else if ((r -= WI_G) < WI_G) { d = WDesc{a.in[3] + oDF, a.in[1] + oD, (bf16_t*)(wl + W_GU1), DM, DFF, 2, -1.0f / LOG2E}; }
        else if ((r -= WI_G) < WI_D) { d = WDesc{a.in[4] + oDF, nullptr, (bf16_t*)(wl + W_D1), DFF, DM, 0, 1.f}; }
        else if ((r -= WI_D) < WI_IN) { d = WDesc{a.in[6] + (size_t)L * DM * 5196, a.in[5] + oD, (bf16_t*)(wl + W_IN), DM, 5196, 3, 0.08838834764831845f * LOG2E}; }
        else if ((r -= WI_IN) < WI_UQ) { d = WDesc{a.in[9] + (size_t)L * 512 * 768, a.in[7] + (size_t)L * 512, (bf16_t*)(wl + W_UQ), 512, 768, 0, 1.f}; }
        else if ((r -= WI_UQ) < WI_UKV) { d = WDesc{a.in[10] + (size_t)L * 256 * 1024, a.in[8] + (size_t)L * 256, (bf16_t*)(wl + W_UKV), 256, 1024, 0, 1.f}; }
        else if ((r -= WI_UKV) < WI_C) { d = WDesc{a.in[25] + (size_t)L * 4096 * 128, nullptr, (bf16_t*)(wl + W_CK), 4096, 128, 0, 1.f}; }
        else if ((r -= WI_C) < WI_C) { d = WDesc{a.in[27] + (size_t)L * 4096 * 128, nullptr, (bf16_t*)(wl + W_CV), 4096, 128, 0, 1.f}; }
        else if ((r -= WI_C) < WI_OUT) { d = WDesc{a.in[33] + (size_t)L * DM * DM, nullptr, (bf16_t*)(wl + W_OUT), DM, DM, 0, 1.f}; }
        else if ((r -= WI_OUT) < WI_G) { d = WDesc{a.in[35] + oDF, a.in[34] + oD, (bf16_t*)(wl + W_GU2), DM, DFF, 1, -LOG2E}; }
        else if ((r -= WI_G) < WI_G) { d = WDesc{a.in[36] + oDF, a.in[34] + oD, (bf16_t*)(wl + W_GU2), DM, DFF, 2, -1.0f / LOG2E}; }
        else { r -= WI_G; d = WDesc{a.in[37] + oDF, nullptr, (bf16_t*)(wl + W_D2), DFF, DM, 0, 1.f}; }
        wt_item(d, scr, r, lane);
    }
}
DI void norm_rows(const float* src, bf16_t* xn, int gw, int NGW, int lane) {
    for (int m = gw; m < NTOK; m += NGW) {
        const f32x4* xr = (const f32x4*)(src + (size_t)m * DM) + lane; f32x4 v[8]; float s = 0.f;
#pragma unroll
        for (int j = 0; j < 8; ++j) { v[j] = xr[64 * j]; s += (v[j].x * v[j].x + v[j].y * v[j].y) + (v[j].z * v[j].z + v[j].w * v[j].w); }
        const float rstd = 1.0f / sqrtf(wave_sum(s) * (1.0f / DM) + EPS);
        u32x2* o = (u32x2*)(xn + (size_t)m * DM) + lane;
#pragma unroll
        for (int j = 0; j < 8; ++j) { u32x2 w; w.x = pk2(v[j].x * rstd, v[j].y * rstd); w.y = pk2(v[j].z * rstd, v[j].w * rstd); o[64 * j] = w; }
    }
}
DI void up8(const u32x4 v, float (&f)[8]) {
    f[0] = bf2f(v.x & 0xffffu); f[1] = bf2f(v.x >> 16); f[2] = bf2f(v.y & 0xffffu); f[3] = bf2f(v.y >> 16);
    f[4] = bf2f(v.z & 0xffffu); f[5] = bf2f(v.z >> 16); f[6] = bf2f(v.w & 0xffffu); f[7] = bf2f(v.w >> 16); }
DI void rope_cs(float ang, float& c, float& s) { const double rev = (double)ang * 0.15915494309189535; const float fr = (float)(rev - __builtin_rint(rev));
    s = __builtin_amdgcn_sinf(fr); c = __builtin_amdgcn_cosf(fr); }
DI void transpose64(const bf16_t* src_row, bf16_t* dst_lane, size_t dpitch) {
#pragma unroll
    for (int i = 0; i < 8; ++i) { const u32x4 v = *(const u32x4*)(src_row + 8 * i); bf16_t* d = dst_lane + (size_t)(8 * i) * dpitch;
        d[0] = (bf16_t)(v.x & 0xffffu); d[dpitch] = (bf16_t)(v.x >> 16); d[2 * dpitch] = (bf16_t)(v.y & 0xffffu); d[3 * dpitch] = (bf16_t)(v.y >> 16);
        d[4 * dpitch] = (bf16_t)(v.z & 0xffffu); d[5 * dpitch] = (bf16_t)(v.z >> 16); d[6 * dpitch] = (bf16_t)(v.w & 0xffffu); d[7 * dpitch] = (bf16_t)(v.w >> 16); }
}
DI void fix1(const Ctx& C, int gw, int NGW, int lane) {
    const Args& a = *C.a; const int L = C.layer;
    const float* kr_g = a.in[14] + L * 64; const float* dq_g = a.in[16] + L * 64; const float* dk_g = a.in[17] + L * 64; const float* nq_g = a.in[23] + L * 128;
    const float* pe_k = a.in[24] + L * 4096; const float* pe_v = a.in[26] + L * 4096; const float* ks_g = a.in[29] + L * 128; const float* kw_g = a.in[30] + L * 128;
    for (int m = gw; m < NTOK; m += NGW) {
        bf16_t* ur = C.U() + (size_t)m * NU; const int b = m >> 12, s = m & 4095; float f[8];
        const int off_kv = lane < 32 ? U_CKV + 8 * lane : U_KR + 8 * (lane & 7);
        const int off_ms = ((lane >> 4) == 0 ? U_KC : (lane >> 4) == 1 ? U_VC : (lane >> 4) == 2 ? U_KS : U_KW) + 8 * (lane & 15);
        const u32x4 r_cq = *(const u32x4*)(ur + U_CQ + 8 * lane), r_kv = *(const u32x4*)(ur + off_kv), r_dq = *(const u32x4*)(ur + U_DQ + 8 * lane),
                    r_dk = *(const u32x4*)(ur + U_DK + 8 * lane), r_nq = *(const u32x4*)(ur + U_NQ + 8 * lane), r_ms = *(const u32x4*)(ur + off_ms);
        { up8(r_cq, f); const float rstd = 1.0f / sqrtf(wave_sum(ssq8(f)) * (1.0f / 512) + EPS);
#pragma unroll
          for (int e = 0; e < 8; ++e) f[e] *= rstd;
          st8(ur + U_CQ + 8 * lane, f); }
        { const int off = off_kv; up8(r_kv, f); const float q = ssq8(f);
          const float tot = wave_sum(lane < 32 ? q : 0.f); const float kq = grp_sum<8>(q);
          float y[8], yp[8];
          const int li = lane & 7;
#pragma unroll
          for (int e = 0; e < 8; ++e) { y[e] = f[e] * (1.0f / sqrtf(kq * (1.0f / 64) + EPS)) * kr_g[8 * li + e]; }
#pragma unroll
          for (int e = 0; e < 8; ++e) yp[e] = __shfl_xor(y[e], 4);
          if (lane < 32) { const float rstd = 1.0f / sqrtf(tot * (1.0f / 256) + EPS);
#pragma unroll
              for (int e = 0; e < 8; ++e) f[e] *= rstd;
              st8(ur + off, f);
          } else if (lane < 40) { float o[8];
#pragma unroll
              for (int e = 0; e < 8; ++e) { float cs, sn; rope_cs((float)s * a.inv_freq[8 * (li & 3) + e], cs, sn); o[e] = (li < 4) ? y[e] * cs - yp[e] * sn : y[e] * cs + yp[e] * sn; }
#pragma unroll
              for (int hh = 0; hh < 4; ++hh) st8(C.KM() + (size_t)m * 768 + hh * 192 + 128 + 8 * li, o); } }
        { up8(r_dq, f); const float rstd = 1.0f / sqrtf(grp_sum<8>(ssq8(f)) * (1.0f / 64) + EPS) * (0.125f * LOG2E);
#pragma unroll
          for (int e = 0; e < 8; ++e) f[e] *= rstd * dq_g[8 * (lane & 7) + e];
          st8(ur + U_DQ + 8 * lane, f);
          up8(r_dk, f); const float rstd2 = 1.0f / sqrtf(grp_sum<8>(ssq8(f)) * (1.0f / 64) + EPS);
#pragma unroll
          for (int e = 0; e < 8; ++e) f[e] *= rstd2 * dk_g[8 * (lane & 7) + e];
          st8(ur + U_DK + 8 * lane, f); }
        { up8(r_nq, f); const float rstd = 1.0f / sqrtf(grp_sum<16>(ssq8(f)) * (1.0f / 128) + EPS) * (0.08838834764831845f * LOG2E);
#pragma unroll
          for (int e = 0; e < 8; ++e) f[e] *= rstd * nq_g[8 * (lane & 15) + e];
          st8(ur + U_NQ + 8 * lane, f); }
        { const int grp = lane >> 4, d0 = 8 * (lane & 15); const int off = off_ms; up8(r_ms, f);
          const float q = grp_sum<16>(ssq8(f));
          if (grp >= 2) { const float* g = grp == 2 ? ks_g : kw_g; const float rstd = 1.0f / sqrtf(q * (1.0f / 128) + EPS);
#pragma unroll
              for (int e = 0; e < 8; ++e) f[e] *= rstd * g[d0 + e];
              st8(ur + off, f);
          } else { const float* pe = grp == 0 ? pe_k : pe_v; bf16_t* A = grp == 0 ? C.AK() : C.AV(); const int n1 = s >> 4, li = s & 15; float o[8];
              if (n1 == 255) {
#pragma unroll
                  for (int e = 0; e < 8; ++e) o[e] = 0.f;
                  st8(A + (size_t)(b * 256 + 255) * 4096 + li * 128 + d0, o); st8(A + (size_t)(b * 256 + 255) * 4096 + (li + 16) * 128 + d0, o);
              } else {
#pragma unroll
                  for (int e = 0; e < 8; ++e) o[e] = f[e] + pe[li * 128 + d0 + e];
                  st8(A + (size_t)(b * 256 + n1) * 4096 + li * 128 + d0, o); }
              if (n1 >= 1) {
#pragma unroll
                  for (int e = 0; e < 8; ++e) o[e] = f[e] + pe[(li + 16) * 128 + d0 + e];
                  st8(A + (size_t)(b * 256 + n1 - 1) * 4096 + (li + 16) * 128 + d0, o); } } }
    }
    for (int it = gw; it < 256 * 19; it += NGW) { const int tg = it / 19, ch = it - tg * 19;     const int m = 64 * tg + lane, b = m >> 12, s = m & 4095;
        int col; bf16_t* dst;
        if (ch < 8) { col = U_DV + 64 * ch; dst = C.VTD() + ((size_t)(b * 4 + (ch >> 1)) * 128 + 64 * (ch & 1)) * SEQ; }
        else if (ch < 10) { col = U_VS + 64 * (ch - 8); dst = C.VTVS() + ((size_t)b * 128 + 64 * (ch - 8)) * SEQ; }
        else if (ch < 12) { col = U_VW + 64 * (ch - 10); dst = C.VTVW() + ((size_t)b * 128 + 64 * (ch - 10)) * SEQ; }
        else { const int c2 = ch - 12; col = U_SV + 64 * c2; dst = C.VTS() + ((size_t)(b * 4 + (c2 >> 1)) * 128 + 64 * (c2 & 1)) * SEQ; }
        transpose64(C.U() + (size_t)m * NU + col, dst + s, SEQ); }
}
DI void fix2(const Ctx& C, int gw, int NGW, int lane) {
    const Args& a = *C.a; const int L = C.layer;
    const float* qn_g = a.in[11] + L * 128; const float* qr_g = a.in[12] + L * 64; const float* kn_g = a.in[13] + L * 128; const float* kc_g = a.in[28] + L * 128;
    const float qscale = 0.07216878364870322f * LOG2E;
    for (int m = gw; m < NTOK; m += NGW) { const int s = m & 4095; float f[8];
        bf16_t* qr = C.QM() + (size_t)m * 768;
        const u32x4 r_qn = *(const u32x4*)(qr + (lane >> 4) * 192 + 8 * (lane & 15)), r_qr = *(const u32x4*)(qr + ((lane & 31) >> 3) * 192 + 128 + 8 * (lane & 7)),
                    r_kn = *(const u32x4*)(C.KVR() + (size_t)m * 1024 + (lane >> 4) * 256 + 8 * (lane & 15));
        { const int hd = lane >> 4, d0 = 8 * (lane & 15); up8(r_qn, f); const float rstd = 1.0f / sqrtf(grp_sum<16>(ssq8(f)) * (1.0f / 128) + EPS) * qscale;
#pragma unroll
          for (int e = 0; e < 8; ++e) f[e] *= rstd * qn_g[d0 + e];
          st8(qr + hd * 192 + d0, f); }
        { const int l5 = lane & 31, hd = l5 >> 3, li = l5 & 7; up8(r_qr, f); const float rstd = 1.0f / sqrtf(grp_sum<8>(ssq8(f)) * (1.0f / 64) + EPS);
          float y[8], yp[8], o[8];
#pragma unroll
          for (int e = 0; e < 8; ++e) y[e] = f[e] * rstd * qr_g[8 * li + e];
#pragma unroll
          for (int e = 0; e < 8; ++e) yp[e] = __shfl_xor(y[e], 4);
#pragma unroll
          for (int e = 0; e < 8; ++e) { float cs, sn; rope_cs((float)s * a.inv_freq[8 * (li & 3) + e], cs, sn); o[e] = ((li < 4) ? y[e] * cs - yp[e] * sn : y[e] * cs + yp[e] * sn) * qscale; }
          if (lane < 32) st8(qr + hd * 192 + 128 + 8 * li, o); }
        { const int hd = lane >> 4, d0 = 8 * (lane & 15); up8(r_kn, f); const float rstd = 1.0f / sqrtf(grp_sum<16>(ssq8(f)) * (1.0f / 128) + EPS);
#pragma unroll
          for (int e = 0; e < 8; ++e) f[e] *= rstd * kn_g[d0 + e];
          st8(C.KM() + (size_t)m * 768 + hd * 192 + d0, f); }
    }
    for (int r4 = gw; r4 < 256; r4 += NGW) { const int row = 4 * r4 + (lane >> 4), d0 = 8 * (lane & 15); float f[8]; ld8(C.KC() + (size_t)row * 128 + d0, f);
        const float rstd = 1.0f / sqrtf(grp_sum<16>(ssq8(f)) * (1.0f / 128) + EPS);
#pragma unroll
        for (int e = 0; e < 8; ++e) f[e] *= rstd * kc_g[d0 + e];
        st8(C.KC() + (size_t)row * 128 + d0, f); }
    for (int it = gw; it < 256 * 8 + 32 + 256; it += NGW) {
        if (it >= 2080) { const int tg = it - 2080; const int m = 64 * tg + lane, b = m >> 12, s = m & 4095;
            transpose64(C.U() + (size_t)m * NU + 5120, C.VTS() + ((size_t)(b * 4 + 3) * 128 + 64) * SEQ + s, SEQ);
        } else if (it < 2048) { const int tg = it >> 3, ch = it & 7; const int m = 64 * tg + lane, b = m >> 12, s = m & 4095;
            transpose64(C.KVR() + (size_t)m * 1024 + (ch >> 1) * 256 + 128 + 64 * (ch & 1), C.VTM() + ((size_t)(b * 4 + (ch >> 1)) * 128 + 64 * (ch & 1)) * SEQ + s, SEQ);
        } else { const int i2 = it - 2048, rg = i2 >> 1, ch = i2 & 1; const int row = 64 * rg + lane, b = row >> 8, n = row & 255;
            transpose64(C.VCR() + (size_t)row * 128 + 64 * ch, C.VTVC() + ((size_t)b * 128 + 64 * ch) * 256 + n, 256); }
    }
}

namespace att {
constexpr float NEG = -1e30f;
constexpr int VP = 72;
constexpr int OFF_K = 0, OFF_V = 25600, OFF_WS = OFF_V + 128 * VP * 2  , OFF_IMP = OFF_WS + 8 * 256  , OFF_SEL = OFF_IMP + 65536  ,
              OFF_MISC = OFF_SEL + 512  , LDS_END = OFF_MISC + 64;
DI int crow(int reg, int h) { return (reg & 3) + 8 * (reg >> 2) + 4 * h; }
#define MFMA32(a, b, c) __builtin_amdgcn_mfma_f32_32x32x16_bf16((a), (b), (c), 0, 0, 0)

struct Pre { u32x4 k[3]; u32x4 v[2]; };
template <int DK> DI void prefetch(int tid, Pre& P, const bf16_t* kg, size_t kpitch, const bf16_t* vg, size_t vpitch, bool with_v) {
    constexpr int PPR = DK / 8;
#pragma unroll
    for (int i = 0; i < (64 * PPR) / 512; ++i) { const int p = tid + i * 512; const int r = p / PPR, c = p - r * PPR; P.k[i] = *(const u32x4*)(kg + (size_t)r * kpitch + c * 8); }
    if (with_v) {
#pragma unroll
        for (int i = 0; i < 2; ++i) { const int p = tid + i * 512; const int r = p >> 3, c = p & 7; P.v[i] = *(const u32x4*)(vg + (size_t)r * vpitch + c * 8); } }
}
template <int DK> DI void commit(int tid, const Pre& P, LAS unsigned char* lds, bool with_v) {
    constexpr int PPR = DK / 8, KP = DK + 8;
#pragma unroll
    for (int i = 0; i < (64 * PPR) / 512; ++i) { const int p = tid + i * 512; const int r = p / PPR, c = p - r * PPR; *(LAS u32x4*)(lds + OFF_K + (r * KP + c * 8) * 2) = P.k[i]; }
    if (with_v) {
#pragma unroll
        for (int i = 0; i < 2; ++i) { const int p = tid + i * 512; const int r = p >> 3, c = p & 7; *(LAS u32x4*)(lds + OFF_V + (r * VP + c * 8) * 2) = P.v[i]; } }
}
template <int DK> DI void qk(f32x16& p0, f32x16& p1, const LAS unsigned char* lds, const bf16x8 (&qf)[DK / 16], int r, int h, float slope2 = 0.f, float b0 = 0.f) {
    constexpr int KP = DK + 8;
    const LAS unsigned char* k0 = lds + OFF_K + (r * KP + 8 * h) * 2; const LAS unsigned char* k1 = k0 + 32 * KP * 2;
#pragma unroll
    for (int e = 0; e < 16; ++e) { p0[e] = fmaf(slope2, (float)((e & 3) + 8 * (e >> 2)), b0); p1[e] = fmaf(slope2, (float)((e & 3) + 8 * (e >> 2) + 32), b0); }
#pragma unroll
    for (int ks = 0; ks < DK / 16; ++ks) { const bf16x8 a0 = *(const LAS bf16x8*)(k0 + ks * 32); const bf16x8 a1 = *(const LAS bf16x8*)(k1 + ks * 32);
        p0 = MFMA32(a0, qf[ks], p0); p1 = MFMA32(a1, qf[ks], p1); }
}
DI bf16x8 pack8(const f32x16& x, int s) {
    u32x4 p; p.x = pk2(x[8 * s], x[8 * s + 1]); p.y = pk2(x[8 * s + 2], x[8 * s + 3]); p.z = pk2(x[8 * s + 4], x[8 * s + 5]); p.w = pk2(x[8 * s + 6], x[8 * s + 7]);
    return __builtin_bit_cast(bf16x8, p); }
DI void pv(f32x16 (&o)[4], const f32x16& p0, const f32x16& p1, const LAS unsigned char* lds, int r, int h) {
    const LAS unsigned char* vb = lds + OFF_V + (r * VP + 4 * h) * 2;
#pragma unroll
    for (int sp = 0; sp < 4; ++sp) { const bf16x8 pa = (sp < 2) ? pack8(p0, sp & 1) : pack8(p1, sp & 1);
#pragma unroll
        for (int db = 0; db < 4; ++db) { const LAS unsigned char* vr = vb + db * 32 * VP * 2 + sp * 32;
            const s16x4 lo = *(const LAS s16x4*)(vr); const s16x4 hi = *(const LAS s16x4*)(vr + 16);
            const bf16x8 vv = __builtin_shufflevector(lo, hi, 0, 1, 2, 3, 4, 5, 6, 7);
            o[db] = MFMA32(pa, vv, o[db]); } }
}
DI void scale_rows(f32x16 (&o)[4], float fac, LAS float* wsf, int r, int h) {
    if (h == 0) wsf[r] = fac;
    LDS_WAIT(); __builtin_amdgcn_wave_barrier();
#pragma unroll
    for (int g = 0; g < 4; ++g) { const f32x4 f4 = *(const LAS f32x4*)(wsf + 8 * g + 4 * h);
#pragma unroll
        for (int db = 0; db < 4; ++db) { o[db][4 * g] *= f4.x; o[db][4 * g + 1] *= f4.y; o[db][4 * g + 2] *= f4.z; o[db][4 * g + 3] *= f4.w; } }
    LDS_WAIT(); __builtin_amdgcn_wave_barrier();
}
DI void stash_store(float* st, const f32x16 (&o)[4], int tid) { f32x4* p = (f32x4*)(st + tid * 64);
#pragma unroll
    for (int db = 0; db < 4; ++db)
#pragma unroll
        for (int g = 0; g < 4; ++g) p[db * 4 + g] = (f32x4){o[db][4 * g], o[db][4 * g + 1], o[db][4 * g + 2], o[db][4 * g + 3]}; }
DI void stash_add(const float* st, f32x16 (&o)[4], int tid) { const f32x4* p = (const f32x4*)(st + tid * 64);
#pragma unroll
    for (int db = 0; db < 4; ++db)
#pragma unroll
        for (int g = 0; g < 4; ++g) { const f32x4 v = p[db * 4 + g]; o[db][4 * g] += v.x; o[db][4 * g + 1] += v.y; o[db][4 * g + 2] += v.z; o[db][4 * g + 3] += v.w; } }
DI float max32(const f32x16& p0, const f32x16& p1) { float a = fmaxf(p0[0], p1[0]);
#pragma unroll
    for (int e = 1; e < 16; ++e) a = fmaxf(a, fmaxf(p0[e], p1[e]));
    return fmaxf(a, __shfl_xor(a, 32)); }
DI void softmax_step(f32x16& p0, f32x16& p1, float& m, float& l, f32x16 (&o)[4], LAS float* wsf, int r, int h, bool has_o) {
    const float mn = fmaxf(m, max32(p0, p1)); const float mu = (mn < 0.5f * NEG) ? 0.f : mn; const float f = __builtin_amdgcn_exp2f(m - mu);
    float s = 0.f;
#pragma unroll
    for (int e = 0; e < 16; ++e) { p0[e] = __builtin_amdgcn_exp2f(p0[e] - mu); p1[e] = __builtin_amdgcn_exp2f(p1[e] - mu); s += p0[e] + p1[e]; }
    l = l * f + s; m = mn;
    if (has_o && __any(f != 1.0f)) scale_rows(o, f, wsf, r, h);
}
DI void finish_write(const f32x16 (&o)[4], const float* gain, float extra, bf16_t* out, size_t pitch, int r, int h) {
    float g[4];
#pragma unroll
    for (int db = 0; db < 4; ++db) g[db] = gain[r + 32 * db] * extra;
#pragma unroll
    for (int reg = 0; reg < 16; ++reg) { float ss = o[0][reg] * o[0][reg] + o[1][reg] * o[1][reg] + o[2][reg] * o[2][reg] + o[3][reg] * o[3][reg];
        ss += __shfl_xor(ss, 1); ss += __shfl_xor(ss, 2); ss += __shfl_xor(ss, 4); ss += __shfl_xor(ss, 8); ss += __shfl_xor(ss, 16);
        const float rstd = 1.0f / sqrtf(ss * (1.0f / 128) + EPS); bf16_t* orow = out + (size_t)crow(reg, h) * pitch + r;
#pragma unroll
        for (int db = 0; db < 4; ++db) orow[32 * db] = (bf16_t)(pk2(o[db][reg] * rstd * g[db], 0.f) & 0xffffu); }
}
DI void zero_o(f32x16 (&o)[4]) {
#pragma unroll
    for (int db = 0; db < 4; ++db)
#pragma unroll
        for (int e = 0; e < 16; ++e) o[db][e] = 0.f; }
DI void causal_mask(f32x16& p0, f32x16& p1, int kv0, int t, int h) {
    const int d0 = kv0 + 4 * h - t;
#pragma unroll
    for (int e = 0; e < 16; ++e) { const int dk = d0 + (e & 3) + 8 * (e >> 2); if (dk > 0) p0[e] = NEG; if (dk + 32 > 0) p1[e] = NEG; }
}
DI void unit_mla(LAS unsigned char* lds, const Ctx& C, int b, int hd, int qb) {
    const int tid = otid(), lane = tid & 63, w = __builtin_amdgcn_readfirstlane(tid >> 6), r = lane & 31, h = lane >> 5;
    LAS float* wsf = (LAS float*)(lds + OFF_WS + w * 256);
    const int t0 = qb * 256 + w * 32, t = t0 + r; const size_t tok = (size_t)b * SEQ + t;
    bf16x8 qf[12];
#pragma unroll
    for (int ks = 0; ks < 12; ++ks) qf[ks] = *(const bf16x8*)(C.QM() + tok * 768 + hd * 192 + 16 * ks + 8 * h);
    const bf16_t* kbase = C.KM() + (size_t)b * SEQ * 768 + hd * 192; const bf16_t* vbase = C.VTM() + (size_t)((b * 4 + hd) * 128) * SEQ;
    f32x16 o[4]; zero_o(o); float m = NEG, l = 0.f; const int nt = 4 * qb + 4;
    Pre P; prefetch<192>(tid, P, kbase, 768, vbase, SEQ, true);
    for (int j = 0; j < nt; ++j) {
        __syncthreads(); commit<192>(tid, P, lds, true); __syncthreads();
        if (j + 1 < nt) prefetch<192>(tid, P, kbase + (size_t)(j + 1) * 64 * 768, 768, vbase + (j + 1) * 64, SEQ, true);
        const int kv0 = 64 * j;
        if (kv0 <= t0 + 31) { f32x16 p0, p1; qk<192>(p0, p1, lds, qf, r, h);
            if (kv0 + 63 > t0) causal_mask(p0, p1, kv0, t, h);
            softmax_step(p0, p1, m, l, o, wsf, r, h, true); pv(o, p0, p1, lds, r, h); }
    }
    l += __shfl_xor(l, 32); scale_rows(o, 1.0f / fmaxf(l, 1e-30f), wsf, r, h);
    finish_write(o, C.a->in[15] + C.layer * 128, 1.f, C.MIX() + ((size_t)b * SEQ + t0) * DM + hd * 128, DM, r, h);
}
DI bool diff_fixed_ok(const Ctx& C) { const int lane = otid() & 63; const Args& a = *C.a; float gq = fabsf(a.in[16][C.layer * 64 + lane]), gk = fabsf(a.in[17][C.layer * 64 + lane]);
#pragma unroll
    for (int of = 1; of < 64; of <<= 1) { gq = fmaxf(gq, __shfl_xor(gq, of)); gk = fmaxf(gk, __shfl_xor(gk, of)); }
    return __builtin_amdgcn_readfirstlane((8.1f * gq * 0.125f * LOG2E) * (8.1f * gk) < 45.0f ? 1 : 0) != 0; }
template <bool FIXED> DI void unit_diff(LAS unsigned char* lds, const Ctx& C, int b, int hd, int qb) {
    const int tid = otid(), lane = tid & 63, w = __builtin_amdgcn_readfirstlane(tid >> 6), r = lane & 31, h = lane >> 5;
    LAS float* wsf = (LAS float*)(lds + OFF_WS + w * 256); const Args& a = *C.a; const int L = C.layer;
    LAS int* votes = (LAS int*)(lds + OFF_MISC + 16);
    const float lam_init = 0.8f - 0.6f * expf(-0.3f * (float)L);
    const float lam = expf(wave_sum(a.in[18][L * 64 + lane] * a.in[19][L * 64 + lane])) - expf(wave_sum(a.in[20][L * 64 + lane] * a.in[21][L * 64 + lane])) + lam_init;
    const float slope2 = exp2f(-(float)(2 * hd + 1)) * LOG2E;
    float kmax = fabsf(a.in[17][L * 64 + lane]);
#pragma unroll
    for (int of = 1; of < 64; of <<= 1) kmax = fmaxf(kmax, __shfl_xor(kmax, of));
    kmax *= 8.1f;
    const int t0 = qb * 256 + w * 32, t = t0 + r; const size_t tok = (size_t)b * SEQ + t;
    const bf16_t* vbase = C.VTD() + (size_t)((b * 4 + hd) * 128) * SEQ;
    float* stash = (float*)(C.ws + WS_STASH) + (size_t)blockIdx.x * 32768; const int nt = 4 * qb + 4;
    f32x16 o[4];
#pragma unroll 1
    for (int which = 0; which < 2; ++which) {
        bf16x8 qf[4]; float qn = 0.f;
#pragma unroll
        for (int ks = 0; ks < 4; ++ks) { qf[ks] = *(const bf16x8*)(C.U() + tok * NU + U_DQ + hd * 128 + which * 64 + 16 * ks + 8 * h);
#pragma unroll
            for (int e = 0; e < 8; ++e) { const float x = bf2f((unsigned)(unsigned short)qf[ks][e]); qn += x * x; } }
        qn += __shfl_xor(qn, 32); const float bq = sqrtf(qn) * kmax;
        const bf16_t* kbase = C.U() + (size_t)b * SEQ * NU + U_DK + hd * 128 + which * 64;
        zero_o(o); float m = NEG, l = 0.f;
        Pre P; prefetch<64>(tid, P, kbase + (size_t)(nt - 1) * 64 * NU, NU, vbase + (nt - 1) * 64, SEQ, true);
        for (int j = nt - 1; j >= 0; --j) {
            __syncthreads();
            if (j < nt - 1) { int alld = 1;
#pragma unroll
                for (int i = 0; i < 8; ++i) alld &= votes[i];
                if (__builtin_amdgcn_readfirstlane(alld)) break; }
            commit<64>(tid, P, lds, true); __syncthreads();
            if (j > 0) prefetch<64>(tid, P, kbase + (size_t)(j - 1) * 64 * NU, NU, vbase + (j - 1) * 64, SEQ, true);
            const int kv0 = 64 * j;
            if (kv0 <= t0 + 31) { f32x16 p0, p1; qk<64>(p0, p1, lds, qf, r, h, slope2, slope2 * (float)(kv0 + 4 * h - t) - (FIXED ? bq : 0.f));
                if (kv0 + 63 > t0) causal_mask(p0, p1, kv0, t, h);
                if constexpr (FIXED) {
                    float sacc = 0.f;
#pragma unroll
                    for (int e = 0; e < 16; ++e) { p0[e] = __builtin_amdgcn_exp2f(p0[e]); p1[e] = __builtin_amdgcn_exp2f(p1[e]); sacc += p0[e] + p1[e]; }
                    l += sacc; m = bq;
                } else softmax_step(p0, p1, m, l, o, wsf, r, h, true);
                pv(o, p0, p1, lds, r, h); }
            { const bool dn = (m > 0.5f * NEG) && (bq - slope2 * (float)(t - kv0 + 1) - m < -160.0f); const int av = __all(dn) ? 1 : 0; if (lane == 0) votes[w] = av; }
        }
        l += __shfl_xor(l, 32); scale_rows(o, (which == 0 ? 1.0f : -lam) / fmaxf(l, 1e-30f), wsf, r, h);
        if (which == 0) stash_store(stash, o, tid); else stash_add(stash, o, tid);
    }
    finish_write(o, a.in[22] + L * 128, 1.0f - lam_init, C.MIX() + ((size_t)b * SEQ + t0) * DM + 512 + hd * 128, DM, r, h);
}
DI float softplus2(float z) { return fmaxf(z, 0.f) + __builtin_amdgcn_logf(1.0f + __builtin_amdgcn_exp2f(-fabsf(z))); }
DI void unit_sb(LAS unsigned char* lds, const Ctx& C, int b, int hd, int qb) {
    const int tid = otid(), lane = tid & 63, w = __builtin_amdgcn_readfirstlane(tid >> 6), r = lane & 31, h = lane >> 5;
    const int t0 = qb * 256 + w * 32, t = t0 + r; const size_t tok = (size_t)b * SEQ + t;
    bf16x8 qf[8];
#pragma unroll
    for (int ks = 0; ks < 8; ++ks) qf[ks] = *(const bf16x8*)(C.U() + tok * NU + U_SQ + hd * 128 + 16 * ks + 8 * h);
    const bf16_t* kbase = C.U() + (size_t)b * SEQ * NU + U_SK + hd * 128; const bf16_t* vbase = C.VTS() + (size_t)((b * 4 + hd) * 128) * SEQ;
    f32x16 o[4]; zero_o(o); float cum = 0.f;
    const int nt = 4 * qb + 4;
    Pre P; prefetch<128>(tid, P, kbase + (size_t)(nt - 1) * 64 * NU, NU, vbase + (nt - 1) * 64, SEQ, true);
    LAS int* votes = (LAS int*)(lds + OFF_MISC + 16);
    for (int j = nt - 1; j >= 0; --j) {
        __syncthreads();
        if (j < nt - 1) { int alld = 1;
#pragma unroll
            for (int i = 0; i < 8; ++i) alld &= votes[i];
            if (__builtin_amdgcn_readfirstlane(alld)) break; }
        commit<128>(tid, P, lds, true); __syncthreads();
        if (j > 0) prefetch<128>(tid, P, kbase + (size_t)(j - 1) * 64 * NU, NU, vbase + (j - 1) * 64, SEQ, true);
        const int kv0 = 64 * j;
        if (kv0 < t0 + 31) { f32x16 p0, p1; qk<128>(p0, p1, lds, qf, r, h);
            const int d0 = kv0 + 4 * h - t; f32x16 s0, s1;
#pragma unroll
            for (int e = 0; e < 16; ++e) { const int dk = d0 + (e & 3) + 8 * (e >> 2); s0[e] = (dk < 0) ? softplus2(p0[e]) : 0.f; s1[e] = (dk + 32 < 0) ? softplus2(p1[e]) : 0.f; }
            float Gs[8], Go[8];
#pragma unroll
            for (int k = 0; k < 4; ++k) { Gs[k] = (s0[4 * k] + s0[4 * k + 1]) + (s0[4 * k + 2] + s0[4 * k + 3]); Gs[k + 4] = (s1[4 * k] + s1[4 * k + 1]) + (s1[4 * k + 2] + s1[4 * k + 3]); }
#pragma unroll
            for (int k = 0; k < 8; ++k) Go[k] = __shfl_xor(Gs[k], 32);
            float T = 0.f;
#pragma unroll
            for (int k = 7; k >= 0; --k) { float base = cum - T - (h == 0 ? Go[k] : 0.f);
                if (k < 4) {
                    float e3 = base;            float e2 = e3 - s0[4 * k + 3]; float e1 = e2 - s0[4 * k + 2]; float e0 = e1 - s0[4 * k + 1];
                    const int dk = d0 + 8 * k;
                    p0[4 * k + 3] = (dk + 3 < 0) ? __builtin_amdgcn_exp2f(p0[4 * k + 3] - s0[4 * k + 3] + e3) : 0.f;
                    p0[4 * k + 2] = (dk + 2 < 0) ? __builtin_amdgcn_exp2f(p0[4 * k + 2] - s0[4 * k + 2] + e2) : 0.f;
                    p0[4 * k + 1] = (dk + 1 < 0) ? __builtin_amdgcn_exp2f(p0[4 * k + 1] - s0[4 * k + 1] + e1) : 0.f;
                    p0[4 * k + 0] = (dk + 0 < 0) ? __builtin_amdgcn_exp2f(p0[4 * k + 0] - s0[4 * k + 0] + e0) : 0.f;
                } else { const int kk = k - 4;
                    float e3 = base;            float e2 = e3 - s1[4 * kk + 3]; float e1 = e2 - s1[4 * kk + 2]; float e0 = e1 - s1[4 * kk + 1];
                    const int dk = d0 + 8 * k;
                    p1[4 * kk + 3] = (dk + 3 < 0) ? __builtin_amdgcn_exp2f(p1[4 * kk + 3] - s1[4 * kk + 3] + e3) : 0.f;
                    p1[4 * kk + 2] = (dk + 2 < 0) ? __builtin_amdgcn_exp2f(p1[4 * kk + 2] - s1[4 * kk + 2] + e2) : 0.f;
                    p1[4 * kk + 1] = (dk + 1 < 0) ? __builtin_amdgcn_exp2f(p1[4 * kk + 1] - s1[4 * kk + 1] + e1) : 0.f;
                    p1[4 * kk + 0] = (dk + 0 < 0) ? __builtin_amdgcn_exp2f(p1[4 * kk + 0] - s1[4 * kk + 0] + e0) : 0.f; }
                T += Gs[k] + Go[k]; }
            cum -= T;
            pv(o, p0, p1, lds, r, h); }
        { const int dn = __all(cum < -160.0f) ? 1 : 0; if (lane == 0) votes[w] = dn; }
    }
    finish_write(o, C.a->in[32] + C.layer * 128, 1.f, C.MIX() + ((size_t)b * SEQ + t0) * DM + 1536 + hd * 128, DM, r, h);
}
DI void cmp_bias_mask(f32x16& p0, f32x16& p1, int n0, int t, int h, float slope2) {
    const int c0 = 16 * (n0 + 4 * h) + 31 - t;
#pragma unroll
    for (int e = 0; e < 16; ++e) { const int ce = c0 + 16 * ((e & 3) + 8 * (e >> 2));
        p0[e] = (ce > 0) ? NEG : fmaf(slope2, (float)ce, p0[e]); p1[e] = (ce + 512 > 0) ? NEG : fmaf(slope2, (float)(ce + 512), p1[e]); }
}
DI void unit_nsa(LAS unsigned char* lds, const Ctx& C, int b, int qb) {
    const int tid = otid(), lane = tid & 63, w = __builtin_amdgcn_readfirstlane(tid >> 6), r = lane & 31, h = lane >> 5, hd = w >> 1, qh = w & 1;
    LAS float* wsf = (LAS float*)(lds + OFF_WS + w * 256); LAS float* imp = (LAS float*)(lds + OFF_IMP); LAS unsigned long long* sel = (LAS unsigned long long*)(lds + OFF_SEL);
    const int t0 = qb * 64 + qh * 32, t = t0 + r, ql = qh * 32 + r; const size_t tok = (size_t)b * SEQ + t;
    bf16x8 qf[8];
#pragma unroll
    for (int ks = 0; ks < 8; ++ks) qf[ks] = *(const bf16x8*)(C.U() + tok * NU + U_NQ + hd * 128 + 16 * ks + 8 * h);
    const bf16_t* gp = C.U() + tok * NU + U_G + hd * 3;
    const float g0 = 1.0f / (1.0f + __expf(-bf2f(gp[0]))), g1 = 1.0f / (1.0f + __expf(-bf2f(gp[1]))), g2 = 1.0f / (1.0f + __expf(-bf2f(gp[2])));
    const float slope2 = exp2f(-(float)(2 * hd + 2)) * LOG2E;
    for (int i = tid; i < 16384; i += 512) imp[i] = 0.f;
    float* stash = (float*)(C.ws + WS_STASH) + (size_t)blockIdx.x * 32768; f32x16 o[4]; Pre P;
    const bf16_t* kcb = C.KC() + (size_t)b * 256 * 128; const bf16_t* vcb = C.VTVC() + (size_t)b * 128 * 256; const int ntc = (4 * qb + 2) / 64 + 1;
    float m = NEG, l = 0.f;
    prefetch<128>(tid, P, kcb, 128, vcb, 256, false);
    for (int j = 0; j < ntc; ++j) {
        __syncthreads(); commit<128>(tid, P, lds, false); __syncthreads();
        if (j + 1 < ntc) prefetch<128>(tid, P, kcb + (size_t)(j + 1) * 64 * 128, 128, vcb, 256, false);
        f32x16 p0, p1; qk<128>(p0, p1, lds, qf, r, h); cmp_bias_mask(p0, p1, 64 * j, t, h, slope2); softmax_step(p0, p1, m, l, o, wsf, r, h, false);
    }
    l += __shfl_xor(l, 32);
    { const float mu = (m < 0.5f * NEG) ? 0.f : m; const float il = 1.0f / fmaxf(l, 1e-30f);
      zero_o(o); prefetch<128>(tid, P, kcb, 128, vcb, 256, true);
      for (int j = 0; j < ntc; ++j) {
          __syncthreads(); commit<128>(tid, P, lds, true); __syncthreads();
          if (j + 1 < ntc) prefetch<128>(tid, P, kcb + (size_t)(j + 1) * 64 * 128, 128, vcb + (j + 1) * 64, 256, true);
          f32x16 p0, p1; qk<128>(p0, p1, lds, qf, r, h); cmp_bias_mask(p0, p1, 64 * j, t, h, slope2);
#pragma unroll
          for (int e = 0; e < 16; ++e) { p0[e] = __builtin_amdgcn_exp2f(p0[e] - mu) * il; p1[e] = __builtin_amdgcn_exp2f(p1[e] - mu) * il; }
#pragma unroll
          for (int g = 0; g < 4; ++g) { const int jb = 16 * j + 2 * g + h; LAS float* ip = imp + hd * 4096 + ql * 64 + jb;
              __hip_atomic_fetch_add(ip, (p0[4 * g] + p0[4 * g + 1]) + (p0[4 * g + 2] + p0[4 * g + 3]), __ATOMIC_RELAXED, __HIP_MEMORY_SCOPE_WORKGROUP);
              __hip_atomic_fetch_add(ip + 1, p0[4 * g + 3], __ATOMIC_RELAXED, __HIP_MEMORY_SCOPE_WORKGROUP);
              __hip_atomic_fetch_add(ip + 8, (p1[4 * g] + p1[4 * g + 1]) + (p1[4 * g + 2] + p1[4 * g + 3]), __ATOMIC_RELAXED, __HIP_MEMORY_SCOPE_WORKGROUP);
              if (jb + 9 < 64) __hip_atomic_fetch_add(ip + 9, p1[4 * g + 3], __ATOMIC_RELAXED, __HIP_MEMORY_SCOPE_WORKGROUP); }
          pv(o, p0, p1, lds, r, h);
      }
      scale_rows(o, g0, wsf, r, h); stash_store(stash, o, tid); }
    __syncthreads();
    for (int qi = 0; qi < 8; ++qi) { const int q = 8 * w + qi; const float v = ((imp[q * 64 + lane] + imp[4096 + q * 64 + lane]) + imp[8192 + q * 64 + lane]) + imp[12288 + q * 64 + lane];
        const bool valid = lane <= qb, forced = (lane == 0) || (lane == qb) || (lane == qb - 1); const float key = forced ? 3.0e38f : v; int rank = 0;
        for (int jj = 0; jj <= qb; ++jj) { const float kj = __shfl(key, jj); rank += ((kj > key) || (kj == key && jj < lane)) ? 1 : 0; }
        const unsigned long long mk = __ballot(valid && rank < 16);
        if (lane == 0) sel[q] = mk; }
    __syncthreads();
    const unsigned long long selq = sel[ql];
    unsigned long long un;
    { unsigned long long u = sel[lane]; unsigned lo = (unsigned)u, hi = (unsigned)(u >> 32);
#pragma unroll
      for (int of = 1; of < 64; of <<= 1) { lo |= __shfl_xor(lo, of); hi |= __shfl_xor(hi, of); }
      un = ((unsigned long long)(unsigned)__builtin_amdgcn_readfirstlane((int)hi) << 32) | (unsigned long long)(unsigned)__builtin_amdgcn_readfirstlane((int)lo); }
    { const bf16_t* kb = C.U() + (size_t)b * SEQ * NU + U_KS; const bf16_t* vb = C.VTVS() + (size_t)b * 128 * SEQ;
      m = NEG; l = 0.f; zero_o(o); unsigned long long rem = un;
      if (rem) { const int j0 = __builtin_ctzll(rem); prefetch<128>(tid, P, kb + (size_t)j0 * 64 * NU, NU, vb + j0 * 64, SEQ, true); }
      while (rem) { const int j = __builtin_ctzll(rem); rem &= rem - 1;
          __syncthreads(); commit<128>(tid, P, lds, true); __syncthreads();
          if (rem) { const int jn = __builtin_ctzll(rem); prefetch<128>(tid, P, kb + (size_t)jn * 64 * NU, NU, vb + jn * 64, SEQ, true); }
          const bool mine = (selq >> j) & 1ull;
          if (__any(mine)) { f32x16 p0, p1; qk<128>(p0, p1, lds, qf, r, h, slope2, slope2 * (float)(64 * j + 4 * h - t)); if (64 * j + 63 > t0) causal_mask(p0, p1, 64 * j, t, h);
              if (!mine) {
#pragma unroll
                  for (int e = 0; e < 16; ++e) { p0[e] = NEG; p1[e] = NEG; } }
              softmax_step(p0, p1, m, l, o, wsf, r, h, true); pv(o, p0, p1, lds, r, h); }
      }
      l += __shfl_xor(l, 32); scale_rows(o, g1 / fmaxf(l, 1e-30f), wsf, r, h); stash_add(stash, o, tid); stash_store(stash, o, tid); }
    { const bf16_t* kb = C.U() + (size_t)b * SEQ * NU + U_KW; const bf16_t* vb = C.VTVW() + (size_t)b * 128 * SEQ;
      m = NEG; l = 0.f; zero_o(o); const int jlo = qb > 8 ? qb - 8 : 0;
      prefetch<128>(tid, P, kb + (size_t)jlo * 64 * NU, NU, vb + jlo * 64, SEQ, true);
      for (int j = jlo; j <= qb; ++j) {
          __syncthreads(); commit<128>(tid, P, lds, true); __syncthreads();
          if (j < qb) prefetch<128>(tid, P, kb + (size_t)(j + 1) * 64 * NU, NU, vb + (j + 1) * 64, SEQ, true);
          const int d0 = 64 * j + 4 * h - t;
          f32x16 p0, p1; qk<128>(p0, p1, lds, qf, r, h, slope2, slope2 * (float)d0);
          if (j == qb || j + 8 <= qb) {
#pragma unroll
              for (int e = 0; e < 16; ++e) { const int dk = d0 + (e & 3) + 8 * (e >> 2);
                  if (dk > 0 || dk <= -512) p0[e] = NEG; if (dk + 32 > 0 || dk + 32 <= -512) p1[e] = NEG; } }
          softmax_step(p0, p1, m, l, o, wsf, r, h, true); pv(o, p0, p1, lds, r, h);
      }
      l += __shfl_xor(l, 32); scale_rows(o, g2 / fmaxf(l, 1e-30f), wsf, r, h); stash_add(stash, o, tid); }
    finish_write(o, C.a->in[31] + C.layer * 128, 1.f, C.MIX() + ((size_t)b * SEQ + t0) * DM + 1024 + hd * 128, DM, r, h);
}
DI void attn_phase(LAS unsigned char* lds, const Ctx& C, unsigned* ctr) {
    LAS int* misc = (LAS int*)(lds + OFF_MISC);
    for (;;) {
        __syncthreads();
        if (otid() == 0) misc[0] = (int)__hip_atomic_fetch_add(ctr, 1u, __ATOMIC_RELAXED, __HIP_MEMORY_SCOPE_AGENT);
        __syncthreads();
        const int p = __builtin_amdgcn_readfirstlane(misc[0]);
        if (p >= 1024) break;
        int type, bh, qb;
        if (p < 256) { type = 3; qb = 63 - (p >> 2); bh = p & 3; }
        else { const int pp = p - 256, g = pp / 48, q = pp - 48 * g; qb = 15 - g; type = q >> 4; bh = q & 15; }
#ifndef NO_DIFF
        if (type == 0) { if (diff_fixed_ok(C)) unit_diff<true>(lds, C, bh >> 2, bh & 3, qb); else unit_diff<false>(lds, C, bh >> 2, bh & 3, qb); }
#endif
#ifndef NO_SB
        if (type == 1) unit_sb(lds, C, bh >> 2, bh & 3, qb);
#endif
#ifndef NO_MLA
        if (type == 2) unit_mla(lds, C, bh >> 2, bh & 3, qb);
#endif
#ifndef NO_NSA
        if (type == 3) unit_nsa(lds, C, bh, qb);
#endif
    }
}
}

#ifndef PROBE_SEAM
#define PROBE_SEAM 0
#endif
#ifndef PROBE_SPIN
#define PROBE_SPIN 0
#endif
#ifndef PROBE_DOUBLE
#define PROBE_DOUBLE 0
#endif
#ifndef PHMASK
#define PHMASK 0xffffffffu
#endif
constexpr int LDS_BYTES = 147456;
static_assert(att::LDS_END <= 131072, "attention LDS map");
#define RLX_AGENT __ATOMIC_RELAXED, __HIP_MEMORY_SCOPE_AGENT
#define XB_TMO      128
#define XB_XCNT(j)  (256  + 64 * (j))
#define XB_XSUB(j)  (1280 + 64 * (j))
#define XB_XGEN(j)  (2304 + 64 * (j))
#define XB_TOP      3328
#define XB_TOPGEN   3392
#define XCD_BAR_WORDS 3456
#define XB_SPIN_CAP (1u << 18)

__device__ __forceinline__ unsigned xb_ld(unsigned* p)              { return __hip_atomic_load(p, __ATOMIC_RELAXED, __HIP_MEMORY_SCOPE_AGENT); }
__device__ __forceinline__ unsigned xb_add(unsigned* p, unsigned v) { return __hip_atomic_fetch_add(p, v, __ATOMIC_RELAXED, __HIP_MEMORY_SCOPE_AGENT); }
__device__ __forceinline__ unsigned xb_xcc_id() { return (unsigned)__builtin_amdgcn_s_getreg((3 << 11) | 20) & 0xFu; }
#define XB_SPIN(cond, bar) do { unsigned _sp = 0; while (cond) { __builtin_amdgcn_s_sleep(1); \
    if ((++_sp & 255u) == 0u) { if (xb_ld(&(bar)[XB_TMO])) break; if (_sp > XB_SPIN_CAP) { atomicAdd(&(bar)[XB_TMO], 1u); break; } } } } while (0)

struct XcdBarrier {
    unsigned* bar; unsigned x;
    volatile LAS unsigned* st;
};

__device__ __forceinline__ XcdBarrier xcd_barrier_post(unsigned* bar, volatile LAS unsigned* st) {
    XcdBarrier b; b.bar = bar; b.x = xb_xcc_id(); b.st = st;
    if (threadIdx.x == 0) (void)xb_add(&bar[XB_XCNT(b.x)], 1u);
    return b;
}
__device__ __forceinline__ void xcd_barrier_complete(unsigned* bar, unsigned x, unsigned& nloc, unsigned& nx) {
    const unsigned G = gridDim.x * gridDim.y * gridDim.z;
    unsigned sum, cnt, mine, sp = 0u;
    for (;;) {
        sum = 0u; cnt = 0u; mine = 0u;
#pragma unroll
        for (unsigned j = 0; j < 16; ++j) { const unsigned c = xb_ld(&bar[XB_XCNT(j)]); sum += c; cnt += (c > 0u) ? 1u : 0u; mine = (j == x) ? c : mine; }
        if (sum == G) break;
        __builtin_amdgcn_s_sleep(1);
        if ((++sp & 255u) == 0u) { if (xb_ld(&bar[XB_TMO])) break; if (sp > XB_SPIN_CAP) { atomicAdd(&bar[XB_TMO], 1u); break; } }
    }
    nloc = mine > 0u ? mine : 1u; nx = cnt > 0u ? cnt : 1u;
}

__device__ __forceinline__ void xcd_barrier(const XcdBarrier& b) {
    asm volatile("s_waitcnt vmcnt(0)" ::: "memory");
    __syncthreads();
    if (threadIdx.x == 0) {
        unsigned* bar = b.bar;
        __builtin_amdgcn_s_waitcnt(0);
        unsigned nloc = b.st[0], nx = b.st[1];
        if (nloc == 0u) { xcd_barrier_complete(bar, b.x, nloc, nx); b.st[0] = nloc; b.st[1] = nx; }
        const unsigned old = xb_add(&bar[XB_XSUB(b.x)], 1u);
        const unsigned gen = old / nloc;
        if (old + 1u == (gen + 1u) * nloc) {
            __builtin_amdgcn_fence(__ATOMIC_RELEASE, "agent");
            asm volatile("s_waitcnt vmcnt(0)" ::: "memory");
            const unsigned og = xb_add(&bar[XB_TOP], 1u);
            const unsigned tg = og / nx;
            if (og + 1u == (tg + 1u) * nx) xb_add(&bar[XB_TOPGEN], 1u);
            else XB_SPIN(xb_ld(&bar[XB_TOPGEN]) == tg, bar);
            __builtin_amdgcn_fence(__ATOMIC_ACQUIRE, "agent");
            xb_add(&bar[XB_XGEN(b.x)], 1u);
            asm volatile("s_waitcnt vmcnt(0)" ::: "memory");
        } else {
            XB_SPIN(xb_ld(&bar[XB_XGEN(b.x)]) == gen, bar);
            __builtin_amdgcn_fence(__ATOMIC_ACQUIRE, "agent");
            asm volatile("s_waitcnt vmcnt(0)" ::: "memory");
        }
    }
    __syncthreads();
}

struct GemmDesc { const bf16_t* A; int lda; const void* Bt; int M, N, K; pg8::EpiAny E; int crot; };
DI GemmDesc get_gemm(const Ctx& C, const Args& a, int s, int gi) {
    unsigned char* wl = C.wl(); float* hres = a.out; GemmDesc d; d.crot = 0;
    d.E.mode = 0; d.E.O = nullptr; d.E.ldc = 0; d.E.ncols = 0; d.E.base = nullptr; d.E.out = nullptr; d.E.alpha = 0.f;
    if (s == 0 || s == 10) { d.A = C.XN(); d.lda = DM; d.Bt = wl + (s == 0 ? W_GU1 : W_GU2); d.M = NTOK; d.N = 2 * DFF; d.K = DM; d.E.mode = 1; d.E.O = C.HID(); d.E.ldc = DFF; }
    else if (s == 1 || s == 11) { d.A = C.HID(); d.lda = DFF; d.Bt = wl + (s == 1 ? W_D1 : W_D2); d.M = NTOK; d.N = DM; d.K = DFF; d.E.mode = 2;
        d.E.base = (s == 1 && C.layer == 0) ? a.in[0] : hres; d.E.out = hres; d.E.ldc = DM; d.E.alpha = 0.5f; }
    else if (s == 3) { d.A = C.XN(); d.lda = DM; d.Bt = wl + W_IN; d.M = NTOK; d.N = 5120; d.K = DM; d.E.O = C.U(); d.E.ldc = NU; d.E.ncols = 5120; }
    else if (s == 8) { d.A = C.MIX(); d.lda = DM; d.Bt = wl + W_OUT; d.M = NTOK; d.N = DM; d.K = DM; d.E.mode = 2; d.E.base = hres; d.E.out = hres; d.E.ldc = DM; d.E.alpha = 1.0f; }
    else if (gi == 0) { d.A = C.U() + U_CQ; d.lda = NU; d.Bt = wl + W_UQ; d.M = NTOK; d.N = 768; d.K = 512; d.E.O = C.QM(); d.E.ldc = 768; d.E.ncols = 768; }
    else if (gi == 1) { d.A = C.U() + U_CKV; d.lda = NU; d.Bt = wl + W_UKV; d.M = NTOK; d.N = 1024; d.K = 256; d.E.O = C.KVR(); d.E.ldc = 1024; d.E.ncols = 1024; }
    else if (gi == 2) { d.A = C.AK(); d.lda = 4096; d.Bt = wl + W_CK; d.M = 1024; d.N = 256; d.K = 4096; d.E.O = C.KC(); d.E.ldc = 128; d.E.ncols = 128; d.crot = 192; }
    else if (gi == 4) { d.A = C.XN(); d.lda = DM; d.Bt = (const bf16_t*)(wl + W_IN) + (size_t)5120 * DM; d.M = NTOK; d.N = 256; d.K = DM; d.E.O = C.U() + 5120; d.E.ldc = NU; d.E.ncols = 256; d.crot = 128; }
    else { d.A = C.AV(); d.lda = 4096; d.Bt = wl + W_CV; d.M = 1024; d.N = 256; d.K = 4096; d.E.O = C.VCR(); d.E.ldc = 128; d.E.ncols = 128; d.crot = 200; }
    return d;
}
__global__ void __launch_bounds__(512, 2) mega_fwd(Args a) {
    extern __shared__ __attribute__((aligned(16))) unsigned char lds_raw[];
    LAS unsigned char* lds = (LAS unsigned char*)lds_raw;
    cg::grid_group grid = cg::this_grid();
    const int NSTEP = 13 * NLAYER;
    volatile LAS unsigned* MISC = (volatile LAS unsigned*)(lds + 131072 + 320);
    if (threadIdx.x < 32) MISC[threadIdx.x] = 0u;
    __syncthreads();
#pragma unroll 1
    for (int step = 0; step < NSTEP; ++step) {
#if PROBE_SPIN
        unsigned long long pt0s = __builtin_amdgcn_s_memrealtime();
#endif
        if (step >= a.ph_lo && step < a.ph_hi) {
#if PROBE_SPIN
            const unsigned long long pt0 = __builtin_amdgcn_s_memrealtime();
#endif
            const int tid = otid(), lane = tid & 63, wave = __builtin_amdgcn_readfirstlane(tid >> 6);
            const int G = gridDim.x, c = blockIdx.x, gw = c * 8 + wave, NGW = G * 8;
            if (step == 1) { const XcdBarrier b0 = xcd_barrier_post((unsigned*)(a.ws + WS_CTL) + 1024, MISC + 8); if (threadIdx.x == 0) MISC[10] = b0.x; }
            if (step == 0) {
                if (blockIdx.x == 0) for (int i = tid; i < 8192; i += 512) ((unsigned*)(a.ws + WS_CTL))[i] = 0u;
#ifndef NO_P0
                for (int rep = 0; rep < (PROBE_DOUBLE == 3 ? 2 : 1); ++rep) p0_weights(a, lds, gw, NGW, wave, lane);
                norm_rows(a.in[0], (bf16_t*)(a.ws + WS_XN), gw, NGW, lane);
#endif
            }
            else {
                const int L = (step - 1) / 13, s = (step - 1) - 13 * L; const Ctx C = make_ctx(a, L);
                const int ng = (s == 0 || s == 1 || s == 3 || s == 8 || s == 10 || s == 11) ? 1 : (s == 5 ? 5 : 0);
                if (ng) {
#pragma unroll 1
                    for (int gi0 = 0; gi0 < ng * ((PROBE_DOUBLE == 2 && (s == 0 || s == 10)) ? 2 : 1); ++gi0) { const int gi = gi0 % ng; const GemmDesc d = get_gemm(C, a, s, gi);
                        pg8::Gemm g{d.A, (const bf16_t*)d.Bt, d.M, d.N, d.K, d.lda}; pg8::StaticOrder S; S.init(d.M, d.N, G, (c + G - (d.crot % G)) % G);
                        pg8::gemm_phase<pg8::EpiAny, pg8::StaticOrder, true, true>(lds, g, S, d.E); }
                }
#ifndef NO_NORM
                else if (s == 2 || s == 9 || s == 12) norm_rows(a.out, C.XN(), gw, NGW, lane);
#endif
#ifndef NO_FIX
                else if (s == 4) fix1(C, gw, NGW, lane);
                else if (s == 6) fix2(C, gw, NGW, lane);
#endif
                else if (s == 7) { att::attn_phase(lds, C, (unsigned*)(a.ws + WS_CTL) + 64 + 64 * L);
#if PROBE_DOUBLE == 1
                    att::attn_phase(lds, C, (unsigned*)(a.ws + WS_CTL) + 256 + 64 * L);
#endif
                }
            }
        }
#if PROBE_SPIN
        {
            int cls; if (step == 0) cls = 1; else { const int s = (step - 1) % 13; cls = (s == 0 || s == 1 || s == 3 || s == 8 || s == 10 || s == 11) ? 2 : (s == 2 || s == 9 || s == 12) ? 4 : (s == 4 || s == 6) ? 8 : (s == 5) ? 16 : 32; }
            if (cls & PROBE_SPIN) { const unsigned long long pt1 = __builtin_amdgcn_s_memrealtime(); const unsigned long long dt = pt1 - pt0s;
                while (__builtin_amdgcn_s_memrealtime() - pt1 < dt) __builtin_amdgcn_s_sleep(8); }
        }
#endif
        if (step >= a.ph_lo && step + 1 < a.ph_hi && step + 1 < NSTEP) { if (step == 0) grid.sync(); else { XcdBarrier bar; bar.bar = (unsigned*)(a.ws + WS_CTL) + 1024; bar.st = MISC + 8; bar.x = MISC[10]; xcd_barrier(bar);
#if PROBE_SEAM
            xcd_barrier(bar); xcd_barrier(bar);
#endif
            } }
    }
}

extern "C" void kernel_launch(void* const* d_in, const int* in_sizes, int n_in, void* d_out, int out_size, void* d_ws, size_t ws_size, hipStream_t stream) {
    static int grid = 0;
    if (grid == 0) {
        if (n_in != 38 || out_size != NTOK * DM || ws_size < WS_END) { fprintf(stderr, "kernel_launch: unexpected shapes (n_in %d, out %d, ws %zu, need %zu)\n", n_in, out_size, ws_size, (size_t)WS_END); grid = -1; return; }
        int dev = 0, cus = 0, per_cu = 0;
        if (hipGetDevice(&dev) != hipSuccess || hipDeviceGetAttribute(&cus, hipDeviceAttributeMultiprocessorCount, dev) != hipSuccess) { grid = -1; return; }
        if (hipFuncSetAttribute((const void*)mega_fwd, hipFuncAttributeMaxDynamicSharedMemorySize, LDS_BYTES) != hipSuccess) { fprintf(stderr, "kernel_launch: hipFuncSetAttribute failed\n"); grid = -1; return; }
        if (hipOccupancyMaxActiveBlocksPerMultiprocessor(&per_cu, (const void*)mega_fwd, 512, LDS_BYTES) != hipSuccess || per_cu < 1) { fprintf(stderr, "kernel_launch: occupancy query says %d\n", per_cu); (void)hipGetLastError(); }
        grid = cus;
    }
    if (grid < 0) return;
    Args a{};
    for (int i = 0; i < 38; ++i) a.in[i] = (const float*)d_in[i];
    a.out = (float*)d_out; a.ws = (unsigned char*)d_ws;
    for (int i = 0; i < 32; ++i) a.inv_freq[i] = (float)pow(10000.0, -(double)(2 * i) / 64.0);
    a.ph_lo = 0; a.ph_hi = 1 << 20;
    void* args[] = {&a};
    hipError_t e = hipLaunchCooperativeKernel((const void*)mega_fwd, dim3(grid), dim3(512), args, LDS_BYTES, stream);
    if (e != hipSuccess) fprintf(stderr, "kernel_launch: cooperative launch failed: %s (grid %d)\n", hipGetErrorString(e), grid);
}
```
